# Optimizing an MI355X kernel written in HIP

```python
import math
import jax, jax.numpy as jnp
from jax import lax
import numpy as np

D_MODEL = 1024
BATCH = 2
SEQ = 8192
DEPTH = 1

CHUNK = 64
CONV_K = 4
EPS = 1e-6

SSD_HEADS = 16
SSD_HEAD_DIM = 64
SSD_WIDTH = SSD_HEADS * SSD_HEAD_DIM
SSD_GROUPS = 2
SSD_STATE = 128
SSD_CONV_DIM = SSD_WIDTH + 2 * SSD_GROUPS * SSD_STATE

GDN_HEADS = 8
GDN_DK = 128
GDN_DV = 128
GDN_KW = GDN_HEADS * GDN_DK
GDN_VW = GDN_HEADS * GDN_DV
GDN_CONV_DIM = 2 * GDN_KW + GDN_VW

MIX_WIDTH = SSD_WIDTH + GDN_VW
IN_SIZES = (SSD_WIDTH, SSD_CONV_DIM, SSD_HEADS, GDN_VW, GDN_CONV_DIM, GDN_HEADS, GDN_HEADS)
IN_DIM = SSD_WIDTH + SSD_CONV_DIM + SSD_HEADS + GDN_VW + GDN_CONV_DIM + 2 * GDN_HEADS

kernel_name = "hybrid_ssd_gated_deltanet_parallel_heads"


def rmsnorm(x, w):
    xf = x.astype(jnp.float32)
    return xf * lax.rsqrt(jnp.mean(xf * xf, axis=-1, keepdims=True) + EPS) * w.astype(jnp.float32)


def l2norm(x):
    return x * lax.rsqrt(jnp.sum(x * x, axis=-1, keepdims=True) + EPS)


def causal_dwconv(x, w):
    return lax.conv_general_dilated(
        x, w[:, None, :].astype(x.dtype), window_strides=(1,), padding=[(CONV_K - 1, 0)],
        dimension_numbers=("NWC", "WIO", "NWC"), feature_group_count=x.shape[-1])


def ssd_chunked(x, dt, a_neg, bm, cm):
    b, t, h, p = x.shape
    g, n = bm.shape[-2:]
    r = h // g
    c = t // CHUNK
    xs = (x * dt[..., None]).reshape(b, c, CHUNK, g, r, p)
    la = jnp.moveaxis((dt * a_neg).reshape(b, c, CHUNK, g, r), 2, -1)
    la_cum = jnp.cumsum(la, axis=-1)
    bc = bm.reshape(b, c, CHUNK, g, n)
    cc = cm.reshape(b, c, CHUNK, g, n)
    idx = jnp.arange(CHUNK)
    incl = idx[:, None] >= idx[None, :]
    lmat = jnp.exp(jnp.where(incl, la_cum[..., :, None] - la_cum[..., None, :], -jnp.inf))
    cb = jnp.einsum("bclgn,bcsgn->bcgls", cc, bc)
    y_diag = jnp.einsum("bcgrls,bcsgrp->bclgrp", cb[:, :, :, None] * lmat, xs)
    states = jnp.einsum("bclgn,bcgrl,bclgrp->bcgrpn", bc, jnp.exp(la_cum[..., -1:] - la_cum), xs)
    chunk_decay = jnp.exp(la_cum[..., -1])

    def step(hst, inp):
        st, dec = inp
        return hst * dec[..., None, None] + st, hst

    h0 = jnp.zeros((b, g, r, p, n), jnp.float32)
    _, prev = lax.scan(step, h0, (jnp.moveaxis(states, 1, 0), jnp.moveaxis(chunk_decay, 1, 0)))
    prev = jnp.moveaxis(prev, 0, 1)
    y_off = jnp.einsum("bclgn,bcgrpn,bcgrl->bclgrp", cc, prev, jnp.exp(la_cum))
    return (y_diag + y_off).reshape(b, t, h, p)


def gated_delta_chunked(q, k, v, g, beta):
    b, t, h, dk = q.shape
    dv = v.shape[-1]
    c = t // CHUNK

    def blk(u):
        return jnp.moveaxis(u.reshape(b, c, CHUNK, h, *u.shape[3:]), 3, 1)

    q, k, v, g, beta = blk(q), blk(k), blk(v), blk(g), blk(beta)
    g_cum = jnp.cumsum(g, axis=-1)
    idx = jnp.arange(CHUNK)
    incl = idx[:, None] >= idx[None, :]
    strict = idx[:, None] > idx[None, :]
    decay = jnp.exp(jnp.where(incl, g_cum[..., :, None] - g_cum[..., None, :], -jnp.inf))
    k_beta = k * beta[..., None]
    a_mat = jnp.where(strict, jnp.einsum("bhcld,bhcsd->bhcls", k_beta, k) * decay, 0.0)
    lhs = a_mat + jnp.eye(CHUNK, dtype=a_mat.dtype)
    rhs = jnp.concatenate([v * beta[..., None], k_beta * jnp.exp(g_cum)[..., None]], axis=-1)
    sol = lax.linalg.triangular_solve(lhs, rhs, left_side=True, lower=True, unit_diagonal=True)
    u_val, w_dec = sol[..., :dv], sol[..., dv:]
    attn = jnp.einsum("bhcld,bhcsd->bhcls", q, k) * decay
    q_dec = q * jnp.exp(g_cum)[..., None]
    k_dec = k * jnp.exp(g_cum[..., -1:] - g_cum)[..., None]
    g_last = jnp.exp(g_cum[..., -1])

    def step(s, inp):
        u_c, w_c, qd_c, kd_c, at_c, gl_c = inp
        v_new = u_c - jnp.einsum("bhld,bhde->bhle", w_c, s)
        o = jnp.einsum("bhld,bhde->bhle", qd_c, s) + jnp.einsum("bhls,bhse->bhle", at_c, v_new)
        s = s * gl_c[..., None, None] + jnp.einsum("bhld,bhle->bhde", kd_c, v_new)
        return s, o

    xs = tuple(jnp.moveaxis(u, 2, 0) for u in (u_val, w_dec, q_dec, k_dec, attn, g_last))
    s0 = jnp.zeros((b, h, dk, dv), jnp.float32)
    _, o = lax.scan(step, s0, xs)
    o = jnp.moveaxis(jnp.moveaxis(o, 0, 2), 1, 3)
    return o.reshape(b, t, h, dv)


def hybrid_layer(hid, norm_w, w_in, ssd_conv_w, ssd_conv_b, ssd_dt_bias, ssd_a_log, ssd_d,
                 ssd_norm_w, gdn_conv_w, gdn_dt_bias, gdn_a_log, gdn_norm_w, w_out):
    b, t, _ = hid.shape
    u = rmsnorm(hid, norm_w).astype(hid.dtype)
    proj = u @ w_in
    splits = np.cumsum(IN_SIZES)[:-1].tolist()
    z, xbc, dt_raw, gate, qkv, a_raw, b_raw = jnp.split(proj, splits, axis=-1)

    xbc = jax.nn.silu(causal_dwconv(xbc, ssd_conv_w) + ssd_conv_b).astype(jnp.float32)
    xs, bm, cm = jnp.split(xbc, [SSD_WIDTH, SSD_WIDTH + SSD_GROUPS * SSD_STATE], axis=-1)
    xs = xs.reshape(b, t, SSD_HEADS, SSD_HEAD_DIM)
    bm = bm.reshape(b, t, SSD_GROUPS, SSD_STATE)
    cm = cm.reshape(b, t, SSD_GROUPS, SSD_STATE)
    dt = jax.nn.softplus(dt_raw.astype(jnp.float32) + ssd_dt_bias.astype(jnp.float32))
    a_neg = -jnp.exp(ssd_a_log.astype(jnp.float32))
    y = ssd_chunked(xs, dt, a_neg, bm, cm) + ssd_d.astype(jnp.float32)[:, None] * xs
    yg = y.reshape(b, t, SSD_GROUPS, SSD_WIDTH // SSD_GROUPS) * jax.nn.silu(
        z.astype(jnp.float32).reshape(b, t, SSD_GROUPS, SSD_WIDTH // SSD_GROUPS))
    yg = yg * lax.rsqrt(jnp.mean(yg * yg, axis=-1, keepdims=True) + EPS)
    y_ssd = yg.reshape(b, t, SSD_WIDTH) * ssd_norm_w.astype(jnp.float32)

    qkv = jax.nn.silu(causal_dwconv(qkv, gdn_conv_w)).astype(jnp.float32)
    q, k, v = jnp.split(qkv, [GDN_KW, 2 * GDN_KW], axis=-1)
    q = l2norm(q.reshape(b, t, GDN_HEADS, GDN_DK)) * (GDN_DK ** -0.5)
    k = l2norm(k.reshape(b, t, GDN_HEADS, GDN_DK))
    v = v.reshape(b, t, GDN_HEADS, GDN_DV)
    beta = jax.nn.sigmoid(b_raw.astype(jnp.float32))
    g = -jnp.exp(gdn_a_log.astype(jnp.float32)) * jax.nn.softplus(
        a_raw.astype(jnp.float32) + gdn_dt_bias.astype(jnp.float32))
    o = gated_delta_chunked(q, k, v, g, beta)
    o = rmsnorm(o, gdn_norm_w) * jax.nn.silu(gate.astype(jnp.float32).reshape(b, t, GDN_HEADS, GDN_DV))
    y_gdn = o.reshape(b, t, GDN_VW)

    mix = jnp.concatenate([y_ssd, y_gdn], axis=-1).astype(hid.dtype)
    return hid + mix @ w_out


def _inv_softplus_dt(key, shape):
    lo, hi = math.log(1e-3), math.log(1e-1)
    dt = jnp.exp(jax.random.uniform(key, shape, jnp.float32) * (hi - lo) + lo)
    dt = jnp.maximum(dt, 1e-4)
    return dt + jnp.log(-jnp.expm1(-dt))


def setup_inputs(seed: int = 0) -> dict:
    key = jax.random.key(seed)
    ks = jax.random.split(key, 16)
    f32 = jnp.float32
    L = DEPTH
    x = jax.random.normal(ks[0], (BATCH, SEQ, D_MODEL), f32)
    norm_w = 1.0 + 0.02 * jax.random.normal(ks[1], (L, D_MODEL), f32)
    w_in = jax.random.normal(ks[2], (L, D_MODEL, IN_DIM), f32) * D_MODEL ** -0.5
    ssd_conv_w = jax.random.normal(ks[3], (L, CONV_K, SSD_CONV_DIM), f32) * CONV_K ** -0.5
    ssd_conv_b = 0.02 * jax.random.normal(ks[4], (L, SSD_CONV_DIM), f32)
    ssd_dt_bias = _inv_softplus_dt(ks[5], (L, SSD_HEADS))
    ssd_a_log = jnp.log(jax.random.uniform(ks[6], (L, SSD_HEADS), f32, 1.0, 16.0))
    ssd_d = 1.0 + 0.02 * jax.random.normal(ks[7], (L, SSD_HEADS), f32)
    ssd_norm_w = 1.0 + 0.02 * jax.random.normal(ks[8], (L, SSD_WIDTH), f32)
    gdn_conv_w = jax.random.normal(ks[9], (L, CONV_K, GDN_CONV_DIM), f32) * CONV_K ** -0.5
    gdn_dt_bias = _inv_softplus_dt(ks[10], (L, GDN_HEADS))
    gdn_a_log = jnp.log(jax.random.uniform(ks[11], (L, GDN_HEADS), f32, 1.0, 16.0))
    gdn_norm_w = 1.0 + 0.02 * jax.random.normal(ks[12], (L, GDN_DV), f32)
    w_out = jax.random.normal(ks[13], (L, MIX_WIDTH, D_MODEL), f32) * MIX_WIDTH ** -0.5
    final_norm_w = 1.0 + 0.02 * jax.random.normal(ks[14], (D_MODEL,), f32)
    return {"x": x, "norm_w": norm_w, "w_in": w_in, "ssd_conv_w": ssd_conv_w,
            "ssd_conv_b": ssd_conv_b, "ssd_dt_bias": ssd_dt_bias, "ssd_a_log": ssd_a_log,
            "ssd_d": ssd_d, "ssd_norm_w": ssd_norm_w, "gdn_conv_w": gdn_conv_w,
            "gdn_dt_bias": gdn_dt_bias, "gdn_a_log": gdn_a_log, "gdn_norm_w": gdn_norm_w,
            "w_out": w_out, "final_norm_w": final_norm_w}


def reference(x, norm_w, w_in, ssd_conv_w, ssd_conv_b, ssd_dt_bias, ssd_a_log, ssd_d, ssd_norm_w,
              gdn_conv_w, gdn_dt_bias, gdn_a_log, gdn_norm_w, w_out, final_norm_w):
    hid = x
    for i in range(DEPTH):
        hid = hybrid_layer(hid, norm_w[i], w_in[i], ssd_conv_w[i], ssd_conv_b[i], ssd_dt_bias[i],
                           ssd_a_log[i], ssd_d[i], ssd_norm_w[i], gdn_conv_w[i], gdn_dt_bias[i],
                           gdn_a_log[i], gdn_norm_w[i], w_out[i])
    return rmsnorm(hid, final_norm_w).astype(x.dtype)
```

```cpp
#include <hip/hip_runtime.h>
#include <hip/hip_cooperative_groups.h>
#include <cstdio>
namespace cg = cooperative_groups;

typedef unsigned short bf16_t;
typedef short bf16x8 __attribute__((ext_vector_type(8)));
typedef short bf16x4 __attribute__((ext_vector_type(4)));
typedef float f32x4 __attribute__((ext_vector_type(4)));
typedef unsigned u32x4 __attribute__((ext_vector_type(4)));
typedef unsigned u32x2 __attribute__((ext_vector_type(2)));

#ifndef N_LAUNCH_MODE
#define N_LAUNCH_MODE 1
#endif

constexpr int NTHR = 512;
constexpr int MTOK = 16384, DM = 1024, LDP = 6656;
constexpr int XBC0 = 1024, GATE0 = 2560, QKV0 = 3584;
constexpr size_t OFF_PROJ = 0;
constexpr size_t OFF_SMALL = OFF_PROJ + (size_t)MTOK * LDP * 2;
constexpr size_t OFF_HALO = OFF_SMALL + (size_t)MTOK * 32 * 4;
constexpr size_t OFF_WOUT = OFF_HALO + (size_t)256 * 3 * 4608 * 2;
constexpr size_t OFF_WIN = OFF_WOUT + (size_t)1024 * 2048 * 2;
constexpr size_t OFF_YPART = OFF_WIN;
constexpr size_t OFF_BAR = OFF_YPART + (size_t)MTOK * 1024 * 2;
constexpr int BAR_BYTES = (19 + 64) * 256;
constexpr size_t OFF_ROWSS = OFF_BAR + BAR_BYTES;
constexpr size_t OFF_S64 = OFF_ROWSS + (size_t)4 * MTOK * 4;
constexpr size_t OFF_H64 = OFF_S64 + (size_t)16 * 128 * 128 * 2;
constexpr size_t OFF_CUM = OFF_H64 + (size_t)32 * 64 * 128 * 2;
constexpr size_t WS_NEED = OFF_CUM + (size_t)32 * 64 * 4;
constexpr size_t OUT_OI_OFF = 50331648;
constexpr size_t OUT_ATTN_OFF = 33554432;
constexpr int LDS_BYTES = 147968;

struct Params {
    const float *x, *norm_w, *w_in, *ssd_conv_w, *ssd_conv_b, *ssd_dt_bias, *ssd_a_log, *ssd_d, *ssd_norm_w,
        *gdn_conv_w, *gdn_dt_bias, *gdn_a_log, *gdn_norm_w, *w_out, *final_norm_w;
    float* out;
    char* ws;
};

#define LAS __attribute__((address_space(3)))
typedef const __attribute__((address_space(4))) Params* PP;

extern __shared__ __attribute__((aligned(16))) char dsm[];

typedef float f32x2 __attribute__((ext_vector_type(2)));
typedef __bf16 bf16x2v __attribute__((ext_vector_type(2)));
__device__ __forceinline__ unsigned pk2(float lo, float hi) {
    const f32x2 v = {lo, hi};
    const bf16x2v b = __builtin_convertvector(v, bf16x2v);
    return __builtin_bit_cast(unsigned, b);
}
__device__ __forceinline__ bf16_t f2bf(float f) { return (bf16_t)(pk2(f, 0.f) & 0xffffu); }
__device__ __forceinline__ float bf2f(bf16_t h) { return __uint_as_float(((unsigned)h) << 16); }
__device__ __forceinline__ float bflo(unsigned u) { return __uint_as_float(u << 16); }
__device__ __forceinline__ float bfhi(unsigned u) { return __uint_as_float(u & 0xffff0000u); }
__device__ __forceinline__ void unpack8(const bf16x8& v, float* f) {
    u32x4 u = __builtin_bit_cast(u32x4, v);
#pragma unroll
    for (int i = 0; i < 4; i++) { f[2 * i] = bflo(u[i]); f[2 * i + 1] = bfhi(u[i]); }
}
__device__ __forceinline__ void unpack4(const bf16x4& v, float* f) {
    u32x2 u = __builtin_bit_cast(u32x2, v);
    f[0] = bflo(u[0]); f[1] = bfhi(u[0]); f[2] = bflo(u[1]); f[3] = bfhi(u[1]);
}
__device__ __forceinline__ u32x4 pack8(const float* f) {
    u32x4 o; o[0] = pk2(f[0], f[1]); o[1] = pk2(f[2], f[3]); o[2] = pk2(f[4], f[5]); o[3] = pk2(f[6], f[7]);
    return o;
}
__device__ __forceinline__ u32x2 pack4(const f32x4& v) {
    u32x2 o; o[0] = pk2(v[0], v[1]); o[1] = pk2(v[2], v[3]);
    return o;
}
__device__ __forceinline__ float wave_sum(float v) {
#pragma unroll
    for (int o = 32; o > 0; o >>= 1) v += __shfl_xor(v, o, 64);
    return v;
}
__device__ __forceinline__ float wave_incl_scan(float v, int lane) {
#pragma unroll
    for (int o = 1; o < 64; o <<= 1) { float t = __shfl_up(v, o, 64); if (lane >= o) v += t; }
    return v;
}
__device__ __forceinline__ float softplus_f(float x) { return x > 20.f ? x : log1pf(expf(x)); }
__device__ __forceinline__ float silu_f(float x) { return x * __builtin_amdgcn_rcpf(1.f + __expf(-x)); }
__device__ __forceinline__ f32x4 mfma16(const bf16x8& a, const bf16x8& b, const f32x4& c) {
    return __builtin_amdgcn_mfma_f32_16x16x32_bf16(a, b, c, 0, 0, 0);
}
__device__ __forceinline__ int tid_opaque() {
    int t = threadIdx.x;
    asm volatile("" : "+v"(t));
    return t;
}
__device__ __forceinline__ unsigned gb_ld(unsigned* q) { return __hip_atomic_load(q, __ATOMIC_RELAXED, __HIP_MEMORY_SCOPE_AGENT); }
__device__ __forceinline__ unsigned gb_add(unsigned* q) { return __hip_atomic_fetch_add(q, 1u, __ATOMIC_RELAXED, __HIP_MEMORY_SCOPE_AGENT); }
__device__ __forceinline__ void fast_grid_barrier(unsigned* bw, unsigned& k) {
    asm volatile("s_waitcnt vmcnt(0)" ::: "memory");
    __syncthreads();
    if (threadIdx.x == 0) {
        const unsigned G = gridDim.x, g = blockIdx.x & 7u;
        const unsigned nloc = (G - g + 7u) >> 3, ngrp = G < 8u ? G : 8u;
        __builtin_amdgcn_fence(__ATOMIC_RELEASE, "agent");
        asm volatile("s_waitcnt vmcnt(0)" ::: "memory");
        unsigned* sub = bw + 64 * (1 + g);
        unsigned* gen = bw + 64 * (9 + g);
        unsigned* top = bw + 64 * 17;
        unsigned* topgen = bw + 64 * 18;
        const unsigned old = gb_add(sub);
        if (old + 1u == (k + 1u) * nloc) {
            const unsigned og = gb_add(top);
            if (og + 1u == (k + 1u) * ngrp) gb_add(topgen);
            else while (gb_ld(topgen) == k) __builtin_amdgcn_s_sleep(1);
            gb_add(gen);
        } else {
            while (gb_ld(gen) == k) __builtin_amdgcn_s_sleep(1);
        }
        __builtin_amdgcn_fence(__ATOMIC_ACQUIRE, "agent");
        asm volatile("s_waitcnt vmcnt(0)" ::: "memory");
    }
    __syncthreads();
    k++;
}
__device__ __forceinline__ void lds_barrier() {
    asm volatile("s_waitcnt lgkmcnt(0)" ::: "memory");
    __builtin_amdgcn_s_barrier();
    asm volatile("" ::: "memory");
}

__device__ __forceinline__ int src_col(int n) {
    if (n < 2560) return n;
    if (n < 6656) return n + 16;
    if (n < 6672) return n - 6656 + 2560;
    if (n < 6688) return n;
    return -1;
}

__device__ __forceinline__ void phase_prep(PP p, const bool zero_bar) {
    LAS float* tile = (LAS float*)dsm;
    const int tid = tid_opaque(), lane = tid & 63, wid = tid >> 6;
    bf16_t* U = (bf16_t*)p->out;
    for (int r0 = (blockIdx.x * 8 + wid) * 4; r0 < MTOK; r0 += gridDim.x * 32) {
        float4 v[4][4];
#pragma unroll
        for (int rr = 0; rr < 4; rr++) {
            const float4* xr = (const float4*)(p->x + (size_t)(r0 + rr) * DM);
#pragma unroll
            for (int i = 0; i < 4; i++) v[rr][i] = xr[lane + 64 * i];
        }
#pragma unroll
        for (int rr = 0; rr < 4; rr++) {
            float ss = 0.f;
#pragma unroll
            for (int i = 0; i < 4; i++) ss += v[rr][i].x * v[rr][i].x + v[rr][i].y * v[rr][i].y + v[rr][i].z * v[rr][i].z + v[rr][i].w * v[rr][i].w;
            ss = wave_sum(ss);
            const float rs = rsqrtf(ss * (1.f / DM) + 1e-6f);
#pragma unroll
            for (int i = 0; i < 4; i++) {
                const float4 w = ((const float4*)p->norm_w)[lane + 64 * i];
                u32x2 o;
                o[0] = pk2(v[rr][i].x * rs * w.x, v[rr][i].y * rs * w.y);
                o[1] = pk2(v[rr][i].z * rs * w.z, v[rr][i].w * rs * w.w);
                *(u32x2*)(U + (size_t)(r0 + rr) * DM + (lane + 64 * i) * 4) = o;
            }
        }
    }
    bf16_t* WIN = (bf16_t*)(p->ws + OFF_WIN);
    bf16_t* WOUT = (bf16_t*)(p->ws + OFF_WOUT);
    const int tend = (gridDim.x == 256) ? 1728 : 1728 + 512;
    auto tload = [&](int t, float (&val)[8]) {
        const bool isin = t < 1728;
        const int tt = isin ? t : t - 1728;
        const int ntile = isin ? tt / 16 : tt / 32, ktile = isin ? tt % 16 : tt % 32;
        const float* src = isin ? p->w_in : p->w_out;
        const int ld = isin ? 6688 : 1024;
#pragma unroll
        for (int it = 0; it < 8; it++) {
            const int e = tid + it * 512, r = e >> 6, c = e & 63, n = ntile * 64 + c;
            const int sc = isin ? src_col(n) : n;
            val[it] = 0.f;
            if (sc >= 0) val[it] = src[(size_t)(ktile * 64 + r) * ld + sc];
        }
    };
    float cur[8], nxt[8];
#pragma unroll
    for (int it = 0; it < 8; it++) { cur[it] = 0.f; nxt[it] = 0.f; }
    if ((int)blockIdx.x < tend) tload(blockIdx.x, cur);
    for (int t = blockIdx.x; t < tend; t += gridDim.x) {
        const bool isin = t < 1728;
        const int tt = isin ? t : t - 1728;
        const int ntile = isin ? tt / 16 : tt / 32, ktile = isin ? tt % 16 : tt % 32;
        const int K = isin ? 1024 : 2048;
        bf16_t* dst = isin ? WIN : WOUT;
#pragma unroll
        for (int it = 0; it < 8; it++) {
            const int e = tid + it * 512, r = e >> 6, c = e & 63;
            tile[r * 65 + c] = cur[it];
        }
        if (t + (int)gridDim.x < tend) tload(t + gridDim.x, nxt);
        __syncthreads();
        {
            const int c = tid >> 3, r0 = (tid & 7) * 8;
            float f[8];
#pragma unroll
            for (int i = 0; i < 8; i++) f[i] = tile[(r0 + i) * 65 + c];
            *(u32x4*)(dst + (size_t)(ntile * 64 + c) * K + ktile * 64 + r0) = pack8(f);
        }
        __syncthreads();
#pragma unroll
        for (int it = 0; it < 8; it++) cur[it] = nxt[it];
    }
}

__device__ __forceinline__ void wout_tiles(PP p, const int start, const int stride) {
    LAS float* tile = (LAS float*)dsm;
    const int tid = tid_opaque();
    bf16_t* WOUT = (bf16_t*)(p->ws + OFF_WOUT);
    for (int tt = start; tt < 512; tt += stride) {
        const int ntile = tt / 32, ktile = tt % 32;
#pragma unroll
        for (int it = 0; it < 8; it++) {
            const int e = tid + it * 512, r = e >> 6, c = e & 63;
            tile[r * 65 + c] = p->w_out[(size_t)(ktile * 64 + r) * 1024 + ntile * 64 + c];
        }
        __syncthreads();
        {
            const int c = tid >> 3, r0 = (tid & 7) * 8;
            float f[8];
#pragma unroll
            for (int i = 0; i < 8; i++) f[i] = tile[(r0 + i) * 65 + c];
            *(u32x4*)(WOUT + (size_t)(ntile * 64 + c) * 2048 + ktile * 64 + r0) = pack8(f);
        }
        __syncthreads();
    }
}

constexpr int HT_ELEMS = 128 * 64;
__device__ __forceinline__ int lds_byte(int r, int c) {
    int st = (r >> 4) * 2 + (c >> 5), rr = r & 15, cc = c & 31, ob = rr * 64 + cc * 2;
    return st * 1024 + (ob ^ (((ob >> 9) & 1) << 5));
}
__device__ __forceinline__ int perm32(int rho) { const int n = rho >> 4, i = rho & 15; return 8 * (i >> 2) + 4 * n + (i & 3); }
__device__ __forceinline__ void stage_rc(int b, int& R, int& C) {
    int st = b / 1024, sb = b % 1024, swz = sb ^ (((sb >> 9) & 1) << 5);
    R = (st >> 1) * 16 + swz / 64;
    C = (st & 1) * 32 + (swz % 64) / 2;
}

template <int GID>
__device__ __forceinline__ void gemm_tile(PP p, const int tid, const int brow, const int bcol) {
    constexpr int K = (GID == 1) ? 1024 : 2048;
    constexpr int LDA = (GID == 1) ? 1024 : LDP;
    constexpr int HALF = 128;
    constexpr int HTB = 128 * 64 * 2;
    LAS unsigned char* lds = (LAS unsigned char*)dsm;
    const int wid = __builtin_amdgcn_readfirstlane(tid >> 6), lane = tid & 63, wr = wid >> 2, wc = wid & 3, fr = lane & 15, fq = lane >> 4;
    unsigned voffA[2], voffB[2];
#pragma unroll
    for (int i = 0; i < 2; ++i) {
        int R, C; stage_rc(tid * 16 + i * 8192, R, C);
        const int Rb = (R & ~31) + perm32(R & 31);
        voffA[i] = (unsigned)(R * LDA + C) * 2u; voffB[i] = (unsigned)(Rb * K + C) * 2u;
    }
    const char* Abase = (GID == 1) ? (const char*)p->out : (const char*)(p->ws + OFF_PROJ);
    const char* cA = Abase + (size_t)brow * LDA * 2;
    const char* cB = (const char*)(p->ws + (GID == 1 ? OFF_WIN : OFF_WOUT)) + (size_t)bcol * K * 2;
    constexpr size_t hstepA = (size_t)HALF * LDA * 2, hstepB = (size_t)HALF * K * 2;
    const unsigned ldsw = (unsigned)wid * 1024u;
    const int aoff = lds_byte(wr * 64 + fr, fq * 8), boff = lds_byte(wc * 32 + fr, fq * 8);
#define AKOFF(kt) ((GID == 1) ? (size_t)(kt) * 128 : ((kt) < 16 ? (size_t)(1024 + (kt) * 64) * 2 : (size_t)(5632 + ((kt) - 16) * 64) * 2))
#define BKOFF(kt) ((size_t)(kt) * 128)
#define SA(b, h) (((b) * 2 + (h)) * HTB)
#define SB(b, h) ((4 + (b) * 2 + (h)) * HTB)
#define STAGE(bufoff, gbase, voff)                                                                                  \
    do {                                                                                                           \
        _Pragma("unroll") for (int _i = 0; _i < 2; ++_i)                                                           \
            __builtin_amdgcn_global_load_lds((const unsigned*)((const char*)(gbase) + (voff)[_i]),                  \
                                             (LAS unsigned*)(lds + (bufoff) + ldsw + _i * 8192), 16, 0, 0);        \
    } while (0)
#define LDA_(dst, b, h)                                                                                             \
    do {                                                                                                           \
        _Pragma("unroll") for (int m = 0; m < 4; ++m) _Pragma("unroll") for (int k = 0; k < 2; ++k)                \
            dst[m][k] = *(const LAS bf16x8*)(lds + SA(b, h) + aoff + m * 2048 + k * 1024);                         \
    } while (0)
#define LDB_(dst, b, h)                                                                                             \
    do {                                                                                                           \
        _Pragma("unroll") for (int n = 0; n < 2; ++n) _Pragma("unroll") for (int k = 0; k < 2; ++k)                \
            dst[n][k] = *(const LAS bf16x8*)(lds + SB(b, h) + boff + n * 2048 + k * 1024);                         \
    } while (0)
#define MMA(ai, bj, At_, Bt_)                                                                                       \
    do {                                                                                                           \
        __builtin_amdgcn_s_setprio(1);                                                                             \
        _Pragma("unroll") for (int m = 0; m < 4; ++m) _Pragma("unroll") for (int n = 0; n < 2; ++n)                \
            _Pragma("unroll") for (int k = 0; k < 2; ++k)                                                          \
                acc[ai][bj][m][n] = __builtin_amdgcn_mfma_f32_16x16x32_bf16(Bt_[n][k], At_[m][k], acc[ai][bj][m][n], 0, 0, 0); \
        __builtin_amdgcn_s_setprio(0);                                                                             \
    } while (0)
#define WAIT_V(n) asm volatile("s_waitcnt vmcnt(" #n ")" ::: "memory")
#define WAIT_L(n) asm volatile("s_waitcnt lgkmcnt(" #n ")" ::: "memory")
#define BAR __builtin_amdgcn_s_barrier()
#define SCHED __builtin_amdgcn_sched_barrier(0)

    f32x4 acc[2][2][4][2];
#pragma unroll
    for (int a = 0; a < 2; ++a)
#pragma unroll
        for (int b = 0; b < 2; ++b)
#pragma unroll
            for (int m = 0; m < 4; ++m)
#pragma unroll
                for (int n = 0; n < 2; ++n) acc[a][b][m][n] = (f32x4){0.f, 0.f, 0.f, 0.f};
    bf16x8 At[4][2], B0[2][2], B1[2][2];
    constexpr int nt = K / 64;
    STAGE(SB(0, 0), cB + BKOFF(0), voffB); STAGE(SA(0, 0), cA + AKOFF(0), voffA);
    STAGE(SB(0, 1), cB + hstepB + BKOFF(0), voffB); STAGE(SA(0, 1), cA + hstepA + AKOFF(0), voffA);
    if (wr == 1) BAR;
    WAIT_V(4); BAR;
    STAGE(SB(1, 0), cB + BKOFF(1), voffB); STAGE(SA(1, 0), cA + AKOFF(1), voffA); STAGE(SB(1, 1), cB + hstepB + BKOFF(1), voffB);
    WAIT_V(6); BAR;
    for (int t = 0; t < nt - 2; t += 2) {
        LDB_(B0, 0, 0); SCHED; LDA_(At, 0, 0); STAGE(SA(1, 1), cA + hstepA + AKOFF(t + 1), voffA);
        WAIT_L(8); BAR; WAIT_L(0); MMA(0, 0, At, B0); BAR; SCHED;
        LDB_(B1, 0, 1); STAGE(SB(0, 0), cB + BKOFF(t + 2), voffB);
        BAR; WAIT_L(0); MMA(0, 1, At, B1); BAR;
        LDA_(At, 0, 1); STAGE(SA(0, 0), cA + AKOFF(t + 2), voffA);
        BAR; WAIT_L(0); MMA(1, 0, At, B0); BAR; SCHED;
        STAGE(SB(0, 1), cB + hstepB + BKOFF(t + 2), voffB);
        WAIT_V(6); BAR; MMA(1, 1, At, B1); BAR;
        LDB_(B0, 1, 0); SCHED; LDA_(At, 1, 0); STAGE(SA(0, 1), cA + hstepA + AKOFF(t + 2), voffA);
        WAIT_L(8); BAR; WAIT_L(0); MMA(0, 0, At, B0); BAR; SCHED;
        LDB_(B1, 1, 1); STAGE(SB(1, 0), cB + BKOFF(t + 3), voffB);
        BAR; WAIT_L(0); MMA(0, 1, At, B1); BAR;
        LDA_(At, 1, 1); STAGE(SA(1, 0), cA + AKOFF(t + 3), voffA);
        BAR; WAIT_L(0); MMA(1, 0, At, B0); BAR; SCHED;
        STAGE(SB(1, 1), cB + hstepB + BKOFF(t + 3), voffB);
        WAIT_V(6); BAR; MMA(1, 1, At, B1); BAR;
    }
    {
        LDB_(B0, 0, 0); LDA_(At, 0, 0); STAGE(SA(1, 1), cA + hstepA + AKOFF(nt - 1), voffA);
        BAR; WAIT_L(0); MMA(0, 0, At, B0); BAR;
        LDB_(B1, 0, 1); BAR; WAIT_L(0); MMA(0, 1, At, B1); BAR;
        LDA_(At, 0, 1); WAIT_V(4); BAR; WAIT_L(0); MMA(1, 0, At, B0); MMA(1, 1, At, B1); BAR;
    }
    {
        LDB_(B0, 1, 0); LDA_(At, 1, 0); WAIT_V(2); BAR; WAIT_L(0); MMA(0, 0, At, B0); BAR;
        LDB_(B1, 1, 1); WAIT_V(0); BAR; WAIT_L(0); MMA(0, 1, At, B1); BAR;
        LDA_(At, 1, 1); BAR; WAIT_L(0); MMA(1, 0, At, B0); MMA(1, 1, At, B1); BAR;
    }
    if (wr == 0) BAR;
    if (GID == 1) {
        if (bcol < 6656) {
            bf16_t* dst0 = (bf16_t*)(p->ws + OFF_PROJ) + (size_t)(brow + wr * 64 + fr) * LDP + bcol + wc * 32 + fq * 4;
#pragma unroll
            for (int ai = 0; ai < 2; ++ai)
#pragma unroll
                for (int m = 0; m < 4; ++m)
#pragma unroll
                    for (int bj = 0; bj < 2; ++bj)
#pragma unroll
                        for (int n = 0; n < 2; ++n)
                            *(u32x2*)(dst0 + (size_t)(ai * HALF + m * 16) * LDP + bj * HALF + n * 16) = pack4(acc[ai][bj][m][n]);
            const int hcb = (bcol >= 3584) ? (bcol - 3584 + 1536) : ((bcol >= 1024 && bcol < 2560) ? (bcol - 1024) : -1);
            if (hcb >= 0 && fr >= 13) {
#pragma unroll
                for (int ai = 0; ai < 2; ++ai) {
                    const int row = brow + ai * HALF + wr * 64 + 48 + fr;
                    bf16_t* hd = (bf16_t*)(p->ws + OFF_HALO) + ((size_t)(row >> 6) * 3 + (fr - 13)) * 4608 + hcb + wc * 32 + fq * 4;
#pragma unroll
                    for (int bj = 0; bj < 2; ++bj)
#pragma unroll
                        for (int n = 0; n < 2; ++n) *(u32x2*)(hd + bj * HALF + n * 16) = pack4(acc[ai][bj][3][n]);
                }
            }
        } else if (wc == 0) {
            float* sd = (float*)(p->ws + OFF_SMALL) + (size_t)(brow + wr * 64 + fr) * 32 + fq * 4;
#pragma unroll
            for (int ai = 0; ai < 2; ++ai)
#pragma unroll
                for (int m = 0; m < 4; ++m)
#pragma unroll
                    for (int n = 0; n < 2; ++n) *(f32x4*)(sd + (size_t)(ai * HALF + m * 16) * 32 + n * 16) = acc[ai][0][m][n];
        }
    } else {
#pragma unroll
        for (int ai = 0; ai < 2; ++ai)
#pragma unroll
            for (int m = 0; m < 4; ++m) {
                const int row = brow + ai * HALF + wr * 64 + m * 16 + fr;
#pragma unroll
                for (int bj = 0; bj < 2; ++bj)
#pragma unroll
                    for (int n = 0; n < 2; ++n) {
                        const int col = bcol + bj * HALF + wc * 32 + fq * 8 + n * 4;
                        const f32x4 xv = *(const f32x4*)(p->x + (size_t)row * DM + col);
                        *(f32x4*)(p->out + (size_t)row * DM + col) = xv + acc[ai][bj][m][n];
                    }
            }
    }
#undef SA
#undef SB
#undef STAGE
#undef LDA_
#undef LDB_
#undef MMA
#undef AKOFF
#undef BKOFF
}


template <int GID>
__device__ __forceinline__ bool gemm_unit(int i, int& pm, int& pn) {
    constexpr int nM = 64, nN = (GID == 1) ? 27 : 4, nwg = nM * nN;
    const long L = (long)i * gridDim.x + blockIdx.x;
    if (L >= nwg) return false;
    int wgid = (int)L;
    {
        const int q = nwg / 8, r = nwg % 8, xcd = wgid % 8, off = wgid / 8;
        wgid = (xcd < r ? xcd * (q + 1) : r * (q + 1) + (xcd - r) * q) + off;
    }
    const int nig = 8 * nN, gid = wgid / nig, fm = gid * 8, gsz = (nM - fm) < 8 ? (nM - fm) : 8;
    pm = fm + ((wgid % nig) % gsz);
    pn = (wgid % nig) / gsz;
    return true;
}

template <int GID>
__device__ __forceinline__ void phase_gemm(PP p, unsigned& bk) {
    constexpr int K = (GID == 1) ? 1024 : 2048;
    constexpr int LDA = (GID == 1) ? 1024 : LDP;
    constexpr int HALF = 128;
    constexpr int HTB = 128 * 64 * 2;
    constexpr int nt = K / 64;
    int pm, pn;
    if (!gemm_unit<GID>(0, pm, pn)) {
        if (GID == 2) fast_grid_barrier((unsigned*)(p->ws + OFF_BAR), bk);
        return;
    }
    LAS unsigned char* lds = (LAS unsigned char*)dsm;
    int tid = threadIdx.x;
    asm volatile("" : "+v"(tid));
    const int wid = __builtin_amdgcn_readfirstlane(tid >> 6), lane = tid & 63, wr = wid >> 2, wc = wid & 3, fr = lane & 15, fq = lane >> 4;
    unsigned voffA[2], voffB[2];
#pragma unroll
    for (int i = 0; i < 2; ++i) {
        int R, C; stage_rc(tid * 16 + i * 8192, R, C);
        const int Rb = (R & ~31) + perm32(R & 31);
        voffA[i] = (unsigned)(R * LDA + C) * 2u; voffB[i] = (unsigned)(Rb * K + C) * 2u;
    }
    const char* Abase = (GID == 1) ? (const char*)p->out : (const char*)(p->ws + OFF_PROJ);
    const char* Bbase = (const char*)(p->ws + (GID == 1 ? OFF_WIN : OFF_WOUT));
    constexpr size_t hstepA = (size_t)HALF * LDA * 2, hstepB = (size_t)HALF * K * 2;
    constexpr size_t tstepA = 2 * hstepA, tstepB = 2 * hstepB;
    const unsigned ldsw = (unsigned)wid * 1024u;
    const int aoff = lds_byte(wr * 64 + fr, fq * 8), boff = lds_byte(wc * 32 + fr, fq * 8);
#define AKOFF(kt) ((GID == 1) ? (size_t)(kt) * 128 : ((kt) < 16 ? (size_t)(1024 + (kt) * 64) * 2 : (size_t)(5632 + ((kt) - 16) * 64) * 2))
#define BKOFF(kt) ((size_t)(kt) * 128)
#define SA(b, h) (((b) * 2 + (h)) * HTB)
#define SB(b, h) ((4 + (b) * 2 + (h)) * HTB)
#define STAGE(bufoff, gbase, voff)                                                                                  \
    do {                                                                                                           \
        _Pragma("unroll") for (int _i = 0; _i < 2; ++_i)                                                           \
            __builtin_amdgcn_global_load_lds((const unsigned*)((const char*)(gbase) + (voff)[_i]),                  \
                                             (LAS unsigned*)(lds + (bufoff) + ldsw + _i * 8192), 16, 0, 0);        \
    } while (0)
#define LDA_(dst, b, h)                                                                                             \
    do {                                                                                                           \
        _Pragma("unroll") for (int m = 0; m < 4; ++m) _Pragma("unroll") for (int k = 0; k < 2; ++k)                \
            dst[m][k] = *(const LAS bf16x8*)(lds + SA(b, h) + aoff + m * 2048 + k * 1024);                         \
    } while (0)
#define LDB_(dst, b, h)                                                                                             \
    do {                                                                                                           \
        _Pragma("unroll") for (int n = 0; n < 2; ++n) _Pragma("unroll") for (int k = 0; k < 2; ++k)                \
            dst[n][k] = *(const LAS bf16x8*)(lds + SB(b, h) + boff + n * 2048 + k * 1024);                         \
    } while (0)
#define MMA(ai, bj, At_, Bt_)                                                                                       \
    do {                                                                                                           \
        __builtin_amdgcn_s_setprio(1);                                                                             \
        _Pragma("unroll") for (int m = 0; m < 4; ++m) _Pragma("unroll") for (int n = 0; n < 2; ++n)                \
            _Pragma("unroll") for (int k = 0; k < 2; ++k)                                                          \
                acc[ai][bj][m][n] = __builtin_amdgcn_mfma_f32_16x16x32_bf16(Bt_[n][k], At_[m][k], acc[ai][bj][m][n], 0, 0, 0); \
        __builtin_amdgcn_s_setprio(0);                                                                             \
    } while (0)
#define WAIT_V(n) asm volatile("s_waitcnt vmcnt(" #n ")" ::: "memory")
#define WAIT_L(n) asm volatile("s_waitcnt lgkmcnt(" #n ")" ::: "memory")
#define BAR __builtin_amdgcn_s_barrier()
#define SCHED __builtin_amdgcn_sched_barrier(0)

    f32x4 acc[2][2][4][2];
#pragma unroll
    for (int a = 0; a < 2; ++a)
#pragma unroll
        for (int b = 0; b < 2; ++b)
#pragma unroll
            for (int m = 0; m < 4; ++m)
#pragma unroll
                for (int n = 0; n < 2; ++n) acc[a][b][m][n] = (f32x4){0.f, 0.f, 0.f, 0.f};
    bf16x8 At[4][2], B0[2][2], B1[2][2];
    const char* cA = Abase + (size_t)pm * tstepA;
    const char* cB = Bbase + (size_t)pn * tstepB;
    STAGE(SB(0, 0), cB + BKOFF(0), voffB); STAGE(SA(0, 0), cA + AKOFF(0), voffA);
    STAGE(SB(0, 1), cB + hstepB + BKOFF(0), voffB); STAGE(SA(0, 1), cA + hstepA + AKOFF(0), voffA);
    if (wr == 1) BAR;
    WAIT_V(4); BAR;
    STAGE(SB(1, 0), cB + BKOFF(1), voffB); STAGE(SA(1, 0), cA + AKOFF(1), voffA); STAGE(SB(1, 1), cB + hstepB + BKOFF(1), voffB);
    WAIT_V(6); BAR;
    for (int ui = 0;; ++ui) {
        int npm, npn;
        const bool has_next = gemm_unit<GID>(ui + 1, npm, npn);
        const char* nA = has_next ? Abase + (size_t)npm * tstepA : cA;
        const char* nB = has_next ? Bbase + (size_t)npn * tstepB : cB;
        for (int t = 0; t < nt; t += 2) {
            const bool last = (t == nt - 2);
            const char* a1 = cA + AKOFF(t + 1);
            const char* a2 = last ? nA + AKOFF(0) : cA + AKOFF(t + 2);
            const char* b2 = last ? nB + BKOFF(0) : cB + BKOFF(t + 2);
            const char* a3 = last ? nA + AKOFF(1) : cA + AKOFF(t + 3);
            const char* b3 = last ? nB + BKOFF(1) : cB + BKOFF(t + 3);
            LDB_(B0, 0, 0); SCHED; LDA_(At, 0, 0); STAGE(SA(1, 1), a1 + hstepA, voffA);
            WAIT_L(8); BAR; WAIT_L(0); MMA(0, 0, At, B0); BAR; SCHED;
            LDB_(B1, 0, 1); STAGE(SB(0, 0), b2, voffB);
            BAR; WAIT_L(0); MMA(0, 1, At, B1); BAR;
            LDA_(At, 0, 1); STAGE(SA(0, 0), a2, voffA);
            BAR; WAIT_L(0); MMA(1, 0, At, B0); BAR; SCHED;
            STAGE(SB(0, 1), b2 + hstepB, voffB);
            WAIT_V(6); BAR; MMA(1, 1, At, B1); BAR;
            LDB_(B0, 1, 0); SCHED; LDA_(At, 1, 0); STAGE(SA(0, 1), a2 + hstepA, voffA);
            WAIT_L(8); BAR; WAIT_L(0); MMA(0, 0, At, B0); BAR; SCHED;
            LDB_(B1, 1, 1); STAGE(SB(1, 0), b3, voffB);
            BAR; WAIT_L(0); MMA(0, 1, At, B1); BAR;
            LDA_(At, 1, 1); STAGE(SA(1, 0), a3, voffA);
            BAR; WAIT_L(0); MMA(1, 0, At, B0); BAR; SCHED;
            STAGE(SB(1, 1), b3 + hstepB, voffB);
            WAIT_V(6); BAR; MMA(1, 1, At, B1); BAR;
        }
        const int brow = pm * 256, bcol = pn * 256;
        if (GID == 1) {
            if (bcol < 6656) {
                bf16_t* dst0 = (bf16_t*)(p->ws + OFF_PROJ) + (size_t)(brow + wr * 64 + fr) * LDP + bcol + wc * 32 + fq * 8;
#pragma unroll
                for (int ai = 0; ai < 2; ++ai)
#pragma unroll
                    for (int m = 0; m < 4; ++m)
#pragma unroll
                        for (int bj = 0; bj < 2; ++bj) {
                            const u32x2 lo = pack4(acc[ai][bj][m][0]), hi = pack4(acc[ai][bj][m][1]);
                            *(u32x4*)(dst0 + (size_t)(ai * HALF + m * 16) * LDP + bj * HALF) = (u32x4){lo[0], lo[1], hi[0], hi[1]};
                        }
                const int hcb = (bcol >= 3584) ? (bcol - 3584 + 1536) : ((bcol >= 1024 && bcol < 2560) ? (bcol - 1024) : -1);
                if (hcb >= 0 && fr >= 13) {
#pragma unroll
                    for (int ai = 0; ai < 2; ++ai) {
                        const int row = brow + ai * HALF + wr * 64 + 48 + fr;
                        bf16_t* hd = (bf16_t*)(p->ws + OFF_HALO) + ((size_t)(row >> 6) * 3 + (fr - 13)) * 4608 + hcb + wc * 32 + fq * 8;
#pragma unroll
                        for (int bj = 0; bj < 2; ++bj) {
                            const u32x2 lo = pack4(acc[ai][bj][3][0]), hi = pack4(acc[ai][bj][3][1]);
                            *(u32x4*)(hd + bj * HALF) = (u32x4){lo[0], lo[1], hi[0], hi[1]};
                        }
                    }
                }
            } else if (wc == 0) {
                float* sd = (float*)(p->ws + OFF_SMALL) + (size_t)(brow + wr * 64 + fr) * 32 + fq * 8;
#pragma unroll
                for (int ai = 0; ai < 2; ++ai)
#pragma unroll
                    for (int m = 0; m < 4; ++m)
#pragma unroll
                        for (int n = 0; n < 2; ++n) *(f32x4*)(sd + (size_t)(ai * HALF + m * 16) * 32 + n * 4) = acc[ai][0][m][n];
            }
        }
        if (!has_next) break;
#pragma unroll
        for (int a = 0; a < 2; ++a)
#pragma unroll
            for (int b = 0; b < 2; ++b)
#pragma unroll
                for (int m = 0; m < 4; ++m)
#pragma unroll
                    for (int n = 0; n < 2; ++n) acc[a][b][m][n] = (f32x4){0.f, 0.f, 0.f, 0.f};
        pm = npm; pn = npn; cA = nA; cB = nB;
    }
    WAIT_V(0);
    if (wr == 0) BAR;
    BAR;
    if (GID == 1 && gridDim.x == 256 && blockIdx.x >= 192) wout_tiles(p, blockIdx.x - 192, 64);
    if (GID == 2) {
        const int brow = pm * 256, bcol = pn * 256;
        LAS float* red = (LAS float*)dsm;
        float* rowss = (float*)(p->ws + OFF_ROWSS);
#pragma unroll
        for (int ai = 0; ai < 2; ++ai)
#pragma unroll
            for (int m = 0; m < 4; ++m) {
                const int rl = ai * HALF + wr * 64 + m * 16 + fr;
                float ss = 0.f;
#pragma unroll
                for (int bj = 0; bj < 2; ++bj)
#pragma unroll
                    for (int n = 0; n < 2; ++n) {
                        const int col = bcol + bj * HALF + wc * 32 + fq * 8 + n * 4;
                        const f32x4 xv = *(const f32x4*)(p->x + (size_t)(brow + rl) * DM + col);
                        f32x4 hv = xv + acc[ai][bj][m][n];
                        acc[ai][bj][m][n] = hv;
                        ss += hv[0] * hv[0] + hv[1] * hv[1] + hv[2] * hv[2] + hv[3] * hv[3];
                    }
                ss += __shfl_xor(ss, 16, 64);
                ss += __shfl_xor(ss, 32, 64);
                if (fq == 0) red[rl * 4 + wc] = ss;
            }
        __syncthreads();
        if (tid < 256) {
            const f32x4 r4 = *(const LAS f32x4*)(red + tid * 4);
            rowss[(size_t)pn * MTOK + brow + tid] = (r4[0] + r4[1]) + (r4[2] + r4[3]);
        }
        if (gridDim.x == 256) {
            asm volatile("s_waitcnt vmcnt(0)" ::: "memory");
            __syncthreads();
            if (threadIdx.x == 0) {
                unsigned* pc = (unsigned*)(p->ws + OFF_BAR) + 64 * (19 + pm);
                __builtin_amdgcn_fence(__ATOMIC_RELEASE, "agent");
                asm volatile("s_waitcnt vmcnt(0)" ::: "memory");
                gb_add(pc);
                while (gb_ld(pc) < 4u) __builtin_amdgcn_s_sleep(1);
                __builtin_amdgcn_fence(__ATOMIC_ACQUIRE, "agent");
                asm volatile("s_waitcnt vmcnt(0)" ::: "memory");
            }
            __syncthreads();
        } else {
            fast_grid_barrier((unsigned*)(p->ws + OFF_BAR), bk);
        }
#pragma unroll
        for (int ai = 0; ai < 2; ++ai)
#pragma unroll
            for (int m = 0; m < 4; ++m) {
                const int row = brow + ai * HALF + wr * 64 + m * 16 + fr;
                const float tot = (rowss[row] + rowss[MTOK + row]) + (rowss[2 * MTOK + row] + rowss[3 * MTOK + row]);
                const float rs = rsqrtf(tot * (1.f / DM) + 1e-6f);
#pragma unroll
                for (int bj = 0; bj < 2; ++bj)
#pragma unroll
                    for (int n = 0; n < 2; ++n) {
                        const int col = bcol + bj * HALF + wc * 32 + fq * 8 + n * 4;
                        const f32x4 wv = *(const f32x4*)(p->final_norm_w + col);
                        *(f32x4*)(p->out + (size_t)row * DM + col) = acc[ai][bj][m][n] * rs * wv;
                    }
            }
    }
#undef SA
#undef SB
#undef STAGE
#undef LDA_
#undef LDB_
#undef MMA
#undef AKOFF
#undef BKOFF
}

__device__ __forceinline__ void conv8x8(const bf16_t* __restrict__ projcol, const bf16_t* __restrict__ halocol, bool first, int l0,
                                        const float* __restrict__ cw, int cwld, const float* __restrict__ bias, float (&val)[8][8]) {
    float w[4][8];
#pragma unroll
    for (int k = 0; k < 4; k++) {
        const float4 a = *(const float4*)(cw + (size_t)k * cwld), b = *(const float4*)(cw + (size_t)k * cwld + 4);
        w[k][0] = a.x; w[k][1] = a.y; w[k][2] = a.z; w[k][3] = a.w; w[k][4] = b.x; w[k][5] = b.y; w[k][6] = b.z; w[k][7] = b.w;
    }
    float bb[8];
#pragma unroll
    for (int i = 0; i < 8; i++) bb[i] = 0.f;
    if (bias) {
        const float4 a = *(const float4*)(bias), b = *(const float4*)(bias + 4);
        bb[0] = a.x; bb[1] = a.y; bb[2] = a.z; bb[3] = a.w; bb[4] = b.x; bb[5] = b.y; bb[6] = b.z; bb[7] = b.w;
    }
    float x0[8], x1[8], x2[8];
#pragma unroll
    for (int i = 0; i < 8; i++) { x0[i] = 0.f; x1[i] = 0.f; x2[i] = 0.f; }
#pragma unroll
    for (int r = -3; r < 8; r++) {
        const int l = l0 + r;
        bf16x8 raw = {0, 0, 0, 0, 0, 0, 0, 0};
        if (l >= 0) raw = *(const bf16x8*)(projcol + (size_t)l * LDP);
        else if (!first) raw = *(const bf16x8*)(halocol + (size_t)(l + 3) * 4608);
        float cur[8];
        unpack8(raw, cur);
        if (r >= 0) {
#pragma unroll
            for (int i = 0; i < 8; i++) {
                const float a = bb[i] + w[0][i] * x0[i] + w[1][i] * x1[i] + w[2][i] * x2[i] + w[3][i] * cur[i];
                val[r][i] = silu_f(a);
            }
        }
#pragma unroll
        for (int i = 0; i < 8; i++) { x0[i] = x1[i]; x1[i] = x2[i]; x2[i] = cur[i]; }
    }
}

template <int VAR>
__device__ __forceinline__ void gdn_item(PP p, const int ch, const int h) {
    LAS char* lb = (LAS char*)dsm;
    asm volatile("" : "+v"(lb));
    LAS bf16_t* QN = (LAS bf16_t*)lb;
    LAS bf16_t* KN = (LAS bf16_t*)(lb + 17408);
    LAS float* VF = (LAS float*)(lb + 34816);
    LAS float* AM = (LAS float*)(lb + 67584);
    LAS float* GC = (LAS float*)(lb + 84992);
    LAS float* BETA = GC + 64;
    LAS float* EG = GC + 128;
    LAS float* TI = (LAS float*)(lb + 85760);
    int tid = threadIdx.x;
    asm volatile("" : "+v"(tid));
    const int lane = tid & 63, wid = tid >> 6, fr = lane & 15, fq = lane >> 4;
    bf16_t* PROJ = (bf16_t*)(p->ws + OFF_PROJ);
    float* SMALL = (float*)(p->ws + OFF_SMALL);
    const bf16_t* HALO = (const bf16_t*)(p->ws + OFF_HALO);
    bf16_t* QD = (bf16_t*)p->out;
    bf16_t* ATTN = (bf16_t*)((char*)p->out + OUT_ATTN_OFF);
    const size_t row0 = (size_t)ch * 64;
    const int item = ch * 8 + h;
    const bool first = (ch & 127) == 0;
    {
        const int g16 = tid >> 4, c8 = tid & 15, blk = g16 >> 3, tr = g16 & 7, l0 = tr * 8;
        if (blk < 3) {
            const int cc = blk * 1024 + h * 128 + c8 * 8;
            float val[8][8];
            conv8x8(PROJ + row0 * LDP + QKV0 + cc, HALO + (size_t)(ch - 1) * 3 * 4608 + 1536 + cc, first, l0,
                    p->gdn_conv_w + cc, 3072, nullptr, val);
            if (blk < 2) {
                LAS bf16_t* ldst = blk == 0 ? QN : KN;
                const float extra = blk == 0 ? 0.08838834764831845f : 1.f;
#pragma unroll
                for (int t = 0; t < 8; t++) {
                    float ss = 0.f;
#pragma unroll
                    for (int i = 0; i < 8; i++) ss += val[t][i] * val[t][i];
                    ss += __shfl_xor(ss, 1, 64); ss += __shfl_xor(ss, 2, 64); ss += __shfl_xor(ss, 4, 64); ss += __shfl_xor(ss, 8, 64);
                    const float sc = rsqrtf(ss + 1e-6f) * extra;
                    float f[8];
#pragma unroll
                    for (int i = 0; i < 8; i++) f[i] = val[t][i] * sc;
                    *(LAS u32x4*)(ldst + (l0 + t) * 136 + c8 * 8) = pack8(f);
                }
            } else {
#pragma unroll
                for (int t = 0; t < 8; t++) {
                    *(LAS f32x4*)(VF + (l0 + t) * 128 + c8 * 8) = (f32x4){val[t][0], val[t][1], val[t][2], val[t][3]};
                    *(LAS f32x4*)(VF + (l0 + t) * 128 + c8 * 8 + 4) = (f32x4){val[t][4], val[t][5], val[t][6], val[t][7]};
                }
            }
        } else if (wid == 7) {
            float* sa = SMALL + (row0 + lane) * 32 + 16 + h;
            const float a_raw = sa[0], b_raw = sa[8];
            const float beta = 1.f / (1.f + expf(-b_raw));
            const float g = -expf(p->gdn_a_log[h]) * softplus_f(a_raw + p->gdn_dt_bias[h]);
            const float gc = wave_incl_scan(g, lane);
            const float eg = expf(gc);
            GC[lane] = gc; BETA[lane] = beta; EG[lane] = eg;
            sa[0] = eg;
        }
    }
    __syncthreads();
    {
        const int i = wid & 3, jj = wid >> 2;
#pragma unroll
        for (int jt = 0; jt < 2; jt++) {
            const int j = jj * 2 + jt;
            f32x4 aK = {0.f, 0.f, 0.f, 0.f}, aQ = {0.f, 0.f, 0.f, 0.f};
            if (j <= i) {
#pragma unroll
                for (int ks = 0; ks < 4; ks++) {
                    const bf16x8 kj = *(const LAS bf16x8*)(KN + (16 * j + fr) * 136 + 32 * ks + 8 * fq);
                    const bf16x8 ki = *(const LAS bf16x8*)(KN + (16 * i + fr) * 136 + 32 * ks + 8 * fq);
                    const bf16x8 qi = *(const LAS bf16x8*)(QN + (16 * i + fr) * 136 + 32 * ks + 8 * fq);
                    aK = mfma16(kj, ki, aK);
                    aQ = mfma16(kj, qi, aQ);
                }
            }
            const int l = 16 * i + fr;
            const float gl_ = GC[l], bl = BETA[l];
            f32x4 am, at;
#pragma unroll
            for (int r = 0; r < 4; r++) {
                const int s = 16 * j + 4 * fq + r;
                const float dec = (l >= s) ? __expf(gl_ - GC[s]) : 0.f;
                am[r] = (l > s) ? bl * aK[r] * dec : 0.f;
                at[r] = (l >= s) ? aQ[r] * dec : 0.f;
            }
            *(LAS f32x4*)(AM + l * 68 + 16 * j + 4 * fq) = am;
            *(u32x2*)(ATTN + ((size_t)item * 64 + l) * 64 + 16 * j + 4 * fq) = pack4(at);
        }
    }
    __syncthreads();
    if (VAR == 13) { __syncthreads(); return; }
    if (wid == 0) {
        const int blk = lane >> 4, j = lane & 15;
        float x[16];
#pragma unroll
        for (int r = 0; r < 16; r++) {
            float v = (r == j) ? 1.f : 0.f;
#pragma unroll
            for (int m4 = 0; m4 * 4 < r; m4++) {
                const f32x4 a = *(const LAS f32x4*)(AM + (16 * blk + r) * 68 + 16 * blk + m4 * 4);
#pragma unroll
                for (int q = 0; q < 4; q++)
                    if (m4 * 4 + q < r) v -= a[q] * x[m4 * 4 + q];
            }
            x[r] = v;
            TI[blk * 256 + r * 16 + j] = v;
        }
    } else if (wid >= 4) {
        const int t2 = tid - 256;
        const float gL = GC[63];
#pragma unroll
        for (int it = 0; it < 4; it++) {
            const int o = t2 + 256 * it, l = o >> 4, d8 = (o & 15) * 8;
            const bf16x8 q = *(const LAS bf16x8*)(QN + l * 136 + d8);
            float f[8];
            unpack8(q, f);
            const float e = EG[l];
#pragma unroll
            for (int i = 0; i < 8; i++) f[i] *= e;
            *(u32x4*)(QD + ((size_t)item * 64 + l) * 128 + d8) = pack8(f);
        }
#pragma unroll
        for (int it = 0; it < 4; it++) {
            const int o = t2 + 256 * it, d = o & 127, l8 = (o >> 7) * 8;
            float f[8];
#pragma unroll
            for (int t = 0; t < 8; t++) f[t] = bf2f(KN[(l8 + t) * 136 + d]) * __expf(gL - GC[l8 + t]);
            *(u32x4*)(PROJ + (row0 + (d >> 1)) * LDP + QKV0 + 1024 + h * 128 + (d & 1) * 64 + l8) = pack8(f);
        }
    }
    __syncthreads();
    {
        const bool isv = wid < 4;
#pragma unroll
        for (int cc = 0; cc < 2; cc++) {
            const int n = 16 * (2 * wid + cc) + fr;
            f32x4 X[4];
#pragma unroll
            for (int i = 0; i < 4; i++) {
                f32x4 acc;
#pragma unroll
                for (int r = 0; r < 4; r++) {
                    const int l = 16 * i + 4 * fq + r;
                    acc[r] = isv ? VF[l * 128 + n] * BETA[l] : bf2f(KN[l * 136 + (n & 127)]) * (BETA[l] * EG[l]);
                }
#pragma unroll
                for (int j = 0; j < i; j++) {
                    const f32x4 av = *(const LAS f32x4*)(AM + (16 * i + fr) * 68 + 16 * j + 4 * fq);
#pragma unroll
                    for (int q = 0; q < 4; q++) acc = __builtin_amdgcn_mfma_f32_16x16x4f32(-av[q], X[j][q], acc, 0, 0, 0);
                }
                const f32x4 tv = *(const LAS f32x4*)(TI + i * 256 + fr * 16 + 4 * fq);
                f32x4 xi = {0.f, 0.f, 0.f, 0.f};
#pragma unroll
                for (int q = 0; q < 4; q++) xi = __builtin_amdgcn_mfma_f32_16x16x4f32(tv[q], acc[q], xi, 0, 0, 0);
                X[i] = xi;
            }
            if (isv) {
                bf16_t* dst = PROJ + (row0 + (n >> 1)) * LDP + QKV0 + 2048 + h * 128 + (n & 1) * 64 + 4 * fq;
#pragma unroll
                for (int i = 0; i < 4; i++) *(u32x2*)(dst + 16 * i) = pack4(X[i]);
            } else {
                bf16_t* dst = PROJ + (row0 + 4 * fq) * LDP + QKV0 + h * 128 + (n & 127);
#pragma unroll
                for (int i = 0; i < 4; i++)
#pragma unroll
                    for (int r = 0; r < 4; r++) dst[(size_t)(16 * i + r) * LDP] = f2bf(X[i][r]);
            }
        }
    }
    __syncthreads();
}

__device__ __forceinline__ int xdt_off(int row, int l) { return row * 72 + ((((l >> 3) ^ ((row >> 3) & 7)) << 3) | (l & 7)); }

template <int VAR>
__device__ __forceinline__ void ssd_item(PP p, const int ch, const int g) {
    LAS char* lb = (LAS char*)dsm;
    asm volatile("" : "+v"(lb));
    LAS float* DT = (LAS float*)lb;
    LAS float* LC = (LAS float*)(lb + 2048);
    LAS bf16_t* XDT = (LAS bf16_t*)(lb + 4096);
    LAS bf16_t* BN = (LAS bf16_t*)(lb + 77824);
    LAS bf16_t* CN = (LAS bf16_t*)(lb + 95232);
    LAS float* CB = (LAS float*)(lb + 112640);
    LAS float* ES = (LAS float*)(lb + 130048);
    int tid = threadIdx.x;
    asm volatile("" : "+v"(tid));
    const int lane = tid & 63, wid = tid >> 6, fr = lane & 15, fq = lane >> 4;
    bf16_t* PROJ = (bf16_t*)(p->ws + OFF_PROJ);
    float* SMALL = (float*)(p->ws + OFF_SMALL);
    const bf16_t* HALO = (const bf16_t*)(p->ws + OFF_HALO);
    bf16_t* YPART = (bf16_t*)(p->ws + OFF_YPART);
    const size_t row0 = (size_t)ch * 64;
    const bool first = (ch & 127) == 0;
    {
        const int hh = 8 * g + wid;
        float* sp = SMALL + (row0 + lane) * 32 + hh;
        const float dt = softplus_f(sp[0] + p->ssd_dt_bias[hh]);
        const float la = -expf(p->ssd_a_log[hh]) * dt;
        const float lc = wave_incl_scan(la, lane);
        DT[wid * 64 + lane] = dt;
        LC[wid * 64 + lane] = lc;
        ES[wid * 64 + lane] = __expf(__shfl(lc, 63, 64) - lc);
        sp[0] = expf(lc);
    }
    __syncthreads();
    for (int task = tid; task < 768; task += 512) {
        const int co = task % 96, tr = task / 96, l0 = tr * 8;
        const int xc = (co < 64) ? g * 512 + co * 8 : (co < 80 ? 1024 + g * 128 + (co - 64) * 8 : 1280 + g * 128 + (co - 80) * 8);
        float val[8][8];
        conv8x8(PROJ + row0 * LDP + XBC0 + xc, HALO + (size_t)(ch - 1) * 3 * 4608 + xc, first, l0,
                p->ssd_conv_w + xc, 1536, p->ssd_conv_b + xc, val);
        if (co < 64) {
            const int hl = co >> 3, p0 = (co & 7) * 8;
            float dtv[8];
#pragma unroll
            for (int t = 0; t < 8; t++) dtv[t] = DT[hl * 64 + l0 + t];
#pragma unroll
            for (int i = 0; i < 8; i++) {
                float f[8];
#pragma unroll
                for (int t = 0; t < 8; t++) f[t] = val[t][i] * dtv[t];
                *(LAS u32x4*)(XDT + xdt_off(hl * 64 + p0 + i, l0)) = pack8(f);
            }
        } else {
            LAS bf16_t* ldst = (co < 80) ? BN : CN;
            const int n0 = ((co - 64) & 15) * 8;
#pragma unroll
            for (int t = 0; t < 8; t++) *(LAS u32x4*)(ldst + (l0 + t) * 136 + n0) = pack8(val[t]);
        }
    }
    __syncthreads();
    if (VAR == 17) { __syncthreads(); return; }
#pragma unroll
    for (int it = 0; it < 8; it++) {
        const int idx = tid + 512 * it, hl = idx >> 9, pp = (idx >> 3) & 63, l0 = (idx & 7) * 8;
        const bf16x8 a = *(const LAS bf16x8*)(XDT + xdt_off(hl * 64 + pp, l0));
        float f[8];
        unpack8(a, f);
        const f32x4 e0 = *(const LAS f32x4*)(ES + hl * 64 + l0), e1 = *(const LAS f32x4*)(ES + hl * 64 + l0 + 4);
#pragma unroll
        for (int t = 0; t < 4; t++) { f[t] *= e0[t]; f[4 + t] *= e1[t]; }
        *(u32x4*)(PROJ + (row0 + pp) * LDP + XBC0 + (8 * g + hl) * 64 + l0) = pack8(f);
    }
#pragma unroll
    for (int it = 0; it < 2; it++) {
        const int idx = tid + 512 * it, n = idx & 127, l0 = (idx >> 7) * 8;
        u32x4 o;
#pragma unroll
        for (int t = 0; t < 4; t++)
            o[t] = (unsigned)BN[(l0 + 2 * t) * 136 + n] | ((unsigned)BN[(l0 + 2 * t + 1) * 136 + n] << 16);
        *(u32x4*)(PROJ + (row0 + (n >> 1)) * LDP + XBC0 + 1024 + g * 128 + (n & 1) * 64 + l0) = o;
    }
#pragma unroll
    for (int it = 0; it < 2; it++) {
        const int idx = tid + 512 * it, l = idx >> 4, n8 = (idx & 15) * 8;
        *(u32x4*)(PROJ + (row0 + l) * LDP + XBC0 + 1280 + g * 128 + n8) = *(const LAS u32x4*)(CN + l * 136 + n8);
    }
    {
        const int i = wid & 3, jj = wid >> 2;
#pragma unroll
        for (int jt = 0; jt < 2; jt++) {
            const int j = jj * 2 + jt;
            f32x4 a = {0.f, 0.f, 0.f, 0.f};
#pragma unroll
            for (int ks = 0; ks < 4; ks++) {
                const bf16x8 bs = *(const LAS bf16x8*)(BN + (16 * j + fr) * 136 + 32 * ks + 8 * fq);
                const bf16x8 cl = *(const LAS bf16x8*)(CN + (16 * i + fr) * 136 + 32 * ks + 8 * fq);
                a = mfma16(bs, cl, a);
            }
            *(LAS f32x4*)(CB + (16 * i + fr) * 68 + 16 * j + 4 * fq) = a;
        }
    }
    __syncthreads();
    if (VAR == 18) { __syncthreads(); return; }
    {
        const int hh = 8 * g + wid;
        f32x4 acc[4][4];
#pragma unroll
        for (int a = 0; a < 4; a++)
#pragma unroll
            for (int b = 0; b < 4; b++) acc[a][b] = (f32x4){0.f, 0.f, 0.f, 0.f};
#pragma unroll
        for (int i = 0; i < 4; i++) {
            const int l = 16 * i + fr;
            const float lcl = LC[wid * 64 + l];
#pragma unroll
            for (int ks = 0; ks < 2; ks++) {
                if (32 * ks > 16 * i + 15) continue;
                const int s0 = 32 * ks + 8 * fq;
                const f32x4 cb0 = *(const LAS f32x4*)(CB + l * 68 + s0), cb1 = *(const LAS f32x4*)(CB + l * 68 + s0 + 4);
                const f32x4 ls0 = *(const LAS f32x4*)(LC + wid * 64 + s0), ls1 = *(const LAS f32x4*)(LC + wid * 64 + s0 + 4);
                float mv[8];
#pragma unroll
                for (int t = 0; t < 4; t++) {
                    mv[t] = (s0 + t <= l) ? cb0[t] * __expf(lcl - ls0[t]) : 0.f;
                    mv[4 + t] = (s0 + 4 + t <= l) ? cb1[t] * __expf(lcl - ls1[t]) : 0.f;
                }
                const bf16x8 mf = __builtin_bit_cast(bf16x8, pack8(mv));
#pragma unroll
                for (int pt = 0; pt < 4; pt++) {
                    const bf16x8 a = *(const LAS bf16x8*)(XDT + xdt_off(wid * 64 + 16 * pt + fr, s0));
                    acc[pt][i] = mfma16(a, mf, acc[pt][i]);
                }
            }
        }
        const float dcoef0 = p->ssd_d[hh];
#pragma unroll
        for (int i = 0; i < 4; i++) {
            const int l = 16 * i + fr;
            const float dcoef = dcoef0 / DT[wid * 64 + l];
#pragma unroll
            for (int pt = 0; pt < 4; pt++) {
                f32x4 v = acc[pt][i];
#pragma unroll
                for (int r = 0; r < 4; r++) v[r] += dcoef * bf2f(XDT[xdt_off(wid * 64 + 16 * pt + 4 * fq + r, l)]);
                *(u32x2*)(YPART + (row0 + l) * 1024 + hh * 64 + 16 * pt + 4 * fq) = pack4(v);
            }
        }
    }
    __syncthreads();
}

template <int VAR>
__device__ __forceinline__ void phase_b(PP p) {
    for (int it = blockIdx.x; it < 2560; it += gridDim.x) {
        if (it < 2048) { if (VAR != 14 && VAR != 17 && VAR != 18) gdn_item<VAR>(p, it >> 3, it & 7); }
        else if (VAR == 0 || VAR == 14) ssd_item<0>(p, (it - 2048) >> 1, (it - 2048) & 1);
        else if (VAR == 17 || VAR == 18) ssd_item<VAR>(p, (it - 2048) >> 1, (it - 2048) & 1);
    }
}

struct GdnOps { bf16x8 wA[4], qA[4], aA[2], kA[2][2]; bf16x4 u; float gl; };

template <int DRY>
__device__ __forceinline__ void gdn_scan(PP p, const int bh, const int es) {
    LAS char* lb = (LAS char*)dsm;
    asm volatile("" : "+v"(lb));
    LAS bf16_t* SBuf = (LAS bf16_t*)lb;
    LAS bf16_t* VN = (LAS bf16_t*)(lb + 8704);
    const int tid = tid_opaque(), lane = tid & 63, wid = tid >> 6, fr = lane & 15, fq = lane >> 4;
    bf16_t* PROJ = (bf16_t*)(p->ws + OFF_PROJ);
    const float* SMALL = (const float*)(p->ws + OFF_SMALL);
    const bf16_t* QD = (const bf16_t*)p->out;
    const bf16_t* ATTN = (const bf16_t*)((const char*)p->out + OUT_ATTN_OFF);
    const int b = bh >> 3, h = bh & 7;
    const int i = wid & 3, jc = wid >> 2;
    const int e_loc = 16 * jc + fr, e = es * 32 + e_loc;
    const int dt0 = 2 * i;
    for (int idx = tid; idx < 32 * 136 / 2; idx += NTHR) ((LAS unsigned*)SBuf)[idx] = 0u;
    f32x4 S0 = {0.f, 0.f, 0.f, 0.f}, S1 = {0.f, 0.f, 0.f, 0.f};

    auto load = [&](int c, GdnOps& o) {
        const int ch = b * 128 + c;
        const size_t row0 = (size_t)ch * 64;
        const int item = ch * 8 + h;
        const bf16_t* wrow = PROJ + (row0 + 16 * i + fr) * LDP + QKV0 + h * 128 + 8 * fq;
        const bf16_t* qrow = QD + ((size_t)item * 64 + 16 * i + fr) * 128 + 8 * fq;
        const bf16_t* arow = ATTN + ((size_t)item * 64 + 16 * i + fr) * 64 + 8 * fq;
#pragma unroll
        for (int ks = 0; ks < 4; ks++) { o.wA[ks] = *(const bf16x8*)(wrow + 32 * ks); o.qA[ks] = *(const bf16x8*)(qrow + 32 * ks); }
#pragma unroll
        for (int ks = 0; ks < 2; ks++) o.aA[ks] = *(const bf16x8*)(arow + 32 * ks);
#pragma unroll
        for (int t = 0; t < 2; t++) {
            const int d = 16 * (dt0 + t) + fr;
            const bf16_t* krow = PROJ + (row0 + (d >> 1)) * LDP + QKV0 + 1024 + h * 128 + (d & 1) * 64 + 8 * fq;
#pragma unroll
            for (int ks = 0; ks < 2; ks++) o.kA[t][ks] = *(const bf16x8*)(krow + 32 * ks);
        }
        o.u = *(const bf16x4*)(PROJ + (row0 + (e >> 1)) * LDP + QKV0 + 2048 + h * 128 + (e & 1) * 64 + 16 * i + 4 * fq);
        o.gl = SMALL[(row0 + 63) * 32 + 16 + h];
    };
    float sink = 0.f;
    GdnOps cur, nxt;
    load(0, cur);
    nxt = cur;
    lds_barrier();
    for (int c = 0; c < 128; c++) {
        if (c + 1 < 128) load(c + 1, nxt);
        f32x4 aP = {0.f, 0.f, 0.f, 0.f}, aO = {0.f, 0.f, 0.f, 0.f};
#pragma unroll
        for (int ks = 0; ks < 4; ks++) {
            const bf16x8 bS = *(const LAS bf16x8*)(SBuf + e_loc * 136 + 32 * ks + 8 * fq);
            aP = mfma16(cur.wA[ks], bS, aP);
            aO = mfma16(cur.qA[ks], bS, aO);
        }
        {
            float uf[4];
            unpack4(cur.u, uf);
            f32x4 vn;
#pragma unroll
            for (int r = 0; r < 4; r++) vn[r] = uf[r] - aP[r];
            *(LAS u32x2*)(VN + e_loc * 72 + 16 * i + 4 * fq) = pack4(vn);
        }
        lds_barrier();
        bf16x8 bV[2];
#pragma unroll
        for (int ks = 0; ks < 2; ks++) bV[ks] = *(const LAS bf16x8*)(VN + e_loc * 72 + 32 * ks + 8 * fq);
#pragma unroll
        for (int ks = 0; ks < 2; ks++) aO = mfma16(cur.aA[ks], bV[ks], aO);
        {
            const size_t row0 = (size_t)(b * 128 + c) * 64;
            bf16_t* od = PROJ + (row0 + (e >> 1)) * LDP + QKV0 + 2048 + h * 128 + (e & 1) * 64 + 16 * i + 4 * fq;
            if (DRY) od = (bf16_t*)((char*)p->out + 52428800 + (((size_t)((char*)od - (char*)PROJ)) & 0x7ffff8));
            if (DRY == 2) sink += aO[0] + aO[1] + aO[2] + aO[3]; else *(u32x2*)od = pack4(aO);
        }
        S0 *= cur.gl; S1 *= cur.gl;
#pragma unroll
        for (int ks = 0; ks < 2; ks++) { S0 = mfma16(cur.kA[0][ks], bV[ks], S0); S1 = mfma16(cur.kA[1][ks], bV[ks], S1); }
        *(LAS u32x2*)(SBuf + e_loc * 136 + 16 * dt0 + 4 * fq) = pack4(S0);
        *(LAS u32x2*)(SBuf + e_loc * 136 + 16 * (dt0 + 1) + 4 * fq) = pack4(S1);
        lds_barrier();
        cur = nxt;
    }
    if (DRY == 2) *(float*)((char*)p->out + 52428800 + (size_t)(blockIdx.x * NTHR + tid) * 4) = sink;
}

struct SsdOps { bf16x8 cB[4], bA[2], xB[4][2]; bf16x4 yp[2]; float elc, dec; };

template <int DRY>
__device__ __forceinline__ void ssd_scan(PP p, const int bh) {
    LAS char* lb = (LAS char*)dsm;
    asm volatile("" : "+v"(lb));
    LAS bf16_t* HT = (LAS bf16_t*)lb;
    const int tid = tid_opaque(), lane = tid & 63, wid = tid >> 6, fr = lane & 15, fq = lane >> 4;
    bf16_t* PROJ = (bf16_t*)(p->ws + OFF_PROJ);
    const float* SMALL = (const float*)(p->ws + OFF_SMALL);
    bf16_t* YPART = (bf16_t*)(p->ws + OFF_YPART);
    const int b = bh >> 4, hh = bh & 15, g = hh >> 3;
    const int i = wid & 3, ptb = 2 * (wid >> 2);
    for (int idx = tid; idx < 64 * 136 / 2; idx += NTHR) ((LAS unsigned*)HT)[idx] = 0u;
    f32x4 hs[4];
#pragma unroll
    for (int t = 0; t < 4; t++) hs[t] = (f32x4){0.f, 0.f, 0.f, 0.f};
    auto load = [&](int c, SsdOps& o) {
        const size_t row0 = (size_t)(b * 128 + c) * 64;
        const bf16_t* crow = PROJ + (row0 + 16 * i + fr) * LDP + XBC0 + 1280 + g * 128 + 8 * fq;
#pragma unroll
        for (int ks = 0; ks < 4; ks++) o.cB[ks] = *(const bf16x8*)(crow + 32 * ks);
        const int n = 16 * wid + fr;
        const bf16_t* brow_ = PROJ + (row0 + (n >> 1)) * LDP + XBC0 + 1024 + g * 128 + (n & 1) * 64 + 8 * fq;
#pragma unroll
        for (int ks = 0; ks < 2; ks++) o.bA[ks] = *(const bf16x8*)(brow_ + 32 * ks);
#pragma unroll
        for (int pt = 0; pt < 4; pt++) {
            const bf16_t* xrow = PROJ + (row0 + 16 * pt + fr) * LDP + XBC0 + hh * 64 + 8 * fq;
#pragma unroll
            for (int ks = 0; ks < 2; ks++) o.xB[pt][ks] = *(const bf16x8*)(xrow + 32 * ks);
        }
#pragma unroll
        for (int t = 0; t < 2; t++) o.yp[t] = *(const bf16x4*)(YPART + (row0 + 16 * i + fr) * 1024 + hh * 64 + 16 * (ptb + t) + 4 * fq);
        o.elc = SMALL[(row0 + 16 * i + fr) * 32 + hh];
        o.dec = SMALL[(row0 + 63) * 32 + hh];
    };
    float sink = 0.f;
    SsdOps cur, nxt;
    load(0, cur);
    nxt = cur;
    lds_barrier();
    for (int c = 0; c < 128; c++) {
        if (c + 1 < 128) load(c + 1, nxt);
        const LAS bf16_t* Hc = HT + (c & 1) * 8704;
        LAS bf16_t* Hn = HT + ((c & 1) ^ 1) * 8704;
        const size_t row0 = (size_t)(b * 128 + c) * 64;
#pragma unroll
        for (int t = 0; t < 2; t++) {
            const int pt = ptb + t;
            f32x4 a = {0.f, 0.f, 0.f, 0.f};
#pragma unroll
            for (int ks = 0; ks < 4; ks++) {
                const bf16x8 hf = *(const LAS bf16x8*)(Hc + (16 * pt + fr) * 136 + 32 * ks + 8 * fq);
                a = mfma16(hf, cur.cB[ks], a);
            }
            float yf[4];
            unpack4(cur.yp[t], yf);
            f32x4 y;
#pragma unroll
            for (int r = 0; r < 4; r++) y[r] = yf[r] + cur.elc * a[r];
            bf16_t* yd = YPART + (row0 + 16 * i + fr) * 1024 + hh * 64 + 16 * pt + 4 * fq;
            if (DRY) yd = (bf16_t*)((char*)p->out + 52428800 + (((size_t)((char*)yd - (char*)YPART)) & 0x7ffff8));
            if (DRY == 2) sink += y[0] + y[1] + y[2] + y[3]; else *(u32x2*)yd = pack4(y);
        }
#pragma unroll
        for (int pt = 0; pt < 4; pt++) {
            hs[pt] *= cur.dec;
#pragma unroll
            for (int ks = 0; ks < 2; ks++) hs[pt] = mfma16(cur.bA[ks], cur.xB[pt][ks], hs[pt]);
            *(LAS u32x2*)(Hn + (16 * pt + fr) * 136 + 16 * wid + 4 * fq) = pack4(hs[pt]);
        }
        lds_barrier();
        cur = nxt;
    }
    if (DRY == 2) *(float*)((char*)p->out + 52428800 + (size_t)(blockIdx.x * NTHR + tid) * 4) = sink;
}


constexpr int G2_SLOT0 = 13376, G2_SLOTB = 67072;
constexpr int G2_W = 0, G2_Q = 17408, G2_K = 34816, G2_A = 53248, G2_U = 62464;
struct GdnStage { u32x4 r[8]; float gl; };

template <int DRY, int MODE>
__device__ __forceinline__ void gdn_scan2(PP p, const int bh, const int es, const int c0) {
    LAS char* lb = (LAS char*)dsm;
    asm volatile("" : "+v"(lb));
    LAS bf16_t* SBuf = (LAS bf16_t*)lb;
    LAS bf16_t* VN = (LAS bf16_t*)(lb + 8704);
    LAS float* GL = (LAS float*)(lb + 13312);
    const int tid = tid_opaque(), lane = tid & 63, wid = __builtin_amdgcn_readfirstlane(tid >> 6), fr = lane & 15, fq = lane >> 4;
    bf16_t* PROJ = (bf16_t*)(p->ws + OFF_PROJ);
    const float* SMALL = (const float*)(p->ws + OFF_SMALL);
    const int b = bh >> 3, h = bh & 7;
    if (MODE == 1) {
        for (int idx = tid; idx < 32 * 136; idx += NTHR) { const int e_ = idx / 136, d_ = idx - e_ * 136; SBuf[idx] = (d_ == es * 32 + e_) ? (bf16_t)0x3F80 : (bf16_t)0; }
    } else {
        for (int idx = tid; idx < 32 * 136 / 2; idx += NTHR) ((LAS unsigned*)SBuf)[idx] = 0u;
    }
    const int lr = tid >> 4, c16 = tid & 15;
    const size_t rowb = (size_t)(b * 128) * 64;
    const char* gW = (const char*)PROJ + ((rowb + lr) * LDP + QKV0 + h * 128) * 2 + c16 * 16;
    const char* gU = (const char*)PROJ + ((rowb + es * 16 + (lr & 15)) * LDP + QKV0 + 2048 + h * 128) * 2 + c16 * 16;
    const char* gQ = (const char*)p->out + ((size_t)(b * 128 * 8 + h)) * 16384 + tid * 16;
    const char* gA = (const char*)p->out + OUT_ATTN_OFF + ((size_t)(b * 128 * 8 + h)) * 8192 + tid * 16;
    const float* gG = SMALL + (rowb + 63) * 32 + 16 + h;
    const unsigned dW = (unsigned)(lr * 136 + c16 * 8) * 2;
    const unsigned dK = (unsigned)((2 * lr + (c16 >> 3)) * 72 + (c16 & 7) * 8) * 2;
    const unsigned dA = (unsigned)((tid >> 3) * 72 + (tid & 7) * 8) * 2;
    const unsigned dU = (unsigned)((2 * (lr & 15) + (c16 >> 3)) * 72 + (c16 & 7) * 8) * 2;
    auto issue = [&](int c, GdnStage& st) {
        c = c > c0 + 63 ? c0 + 63 : c;
        if (DRY == 3) c = 0;
        const int cs = (DRY == 4) ? 0 : c, cq = (DRY == 5) ? 0 : c;
        const size_t co = (size_t)cs * 64 * LDP * 2;
#pragma unroll
        for (int j = 0; j < 2; j++) st.r[j] = *(const u32x4*)(gW + co + (size_t)j * 32 * LDP * 2);
#pragma unroll
        for (int j = 0; j < 2; j++) st.r[2 + j] = *(const u32x4*)(gW + 2048 + co + (size_t)j * 32 * LDP * 2);
#pragma unroll
        for (int j = 0; j < 2; j++) st.r[4 + j] = *(const u32x4*)(gQ + (size_t)cq * 8 * 16384 + j * 8192);
        st.r[6] = *(const u32x4*)(gA + (size_t)cq * 8 * 8192);
        if (wid < 4) st.r[7] = *(const u32x4*)(gU + co);
        st.gl = gG[(size_t)c * 64 * 32];
    };
    auto commit = [&](const GdnStage& st, int slot) {
        LAS char* sb = lb + G2_SLOT0 + slot * G2_SLOTB;
#pragma unroll
        for (int j = 0; j < 2; j++) *(LAS u32x4*)(sb + G2_W + dW + j * 32 * 272) = st.r[j];
#pragma unroll
        for (int j = 0; j < 2; j++) *(LAS u32x4*)(sb + G2_K + dK + j * 64 * 144) = st.r[2 + j];
#pragma unroll
        for (int j = 0; j < 2; j++) *(LAS u32x4*)(sb + G2_Q + dW + j * 32 * 272) = st.r[4 + j];
        *(LAS u32x4*)(sb + G2_A + dA) = st.r[6];
        if (wid < 4) *(LAS u32x4*)(sb + G2_U + dU) = st.r[7];
        if (tid == 0) GL[slot] = st.gl;
    };
    const int i = wid & 3, jc = wid >> 2;
    const int e_loc = 16 * jc + fr, e = es * 32 + e_loc;
    const int dt0 = 2 * i;
    f32x4 S0 = {0.f, 0.f, 0.f, 0.f}, S1 = {0.f, 0.f, 0.f, 0.f};
    if (MODE == 1) {
#pragma unroll
        for (int r = 0; r < 4; r++) {
            S0[r] = (16 * dt0 + 4 * fq + r == es * 32 + e_loc) ? 1.f : 0.f;
            S1[r] = (16 * (dt0 + 1) + 4 * fq + r == es * 32 + e_loc) ? 1.f : 0.f;
        }
    }
    float sink = 0.f;
    GdnStage R0, R1, R2, R3;
#pragma unroll
    for (int j = 0; j < 8; j++) { R0.r[j] = (u32x4){0u, 0u, 0u, 0u}; R1.r[j] = R0.r[j]; R2.r[j] = R0.r[j]; R3.r[j] = R0.r[j]; }
    issue(c0, R0);
    commit(R0, 0);
    issue(c0 + 1, R1); issue(c0 + 2, R2); issue(c0 + 3, R3);
    lds_barrier();
    auto step = [&](const int c, GdnStage& R, GdnStage& RI) {
        const int slot = c & 1;
        LAS char* sb = lb + G2_SLOT0 + slot * G2_SLOTB;
        commit(R, slot ^ 1);
        issue(c + 4, RI);
        f32x4 aP = {0.f, 0.f, 0.f, 0.f}, aO = {0.f, 0.f, 0.f, 0.f};
#pragma unroll
        for (int ks = 0; ks < 4; ks++) {
            const bf16x8 aw = *(const LAS bf16x8*)(sb + G2_W + ((16 * i + fr) * 136 + 32 * ks + 8 * fq) * 2);
            const bf16x8 aq = *(const LAS bf16x8*)(sb + G2_Q + ((16 * i + fr) * 136 + 32 * ks + 8 * fq) * 2);
            const bf16x8 bS = *(const LAS bf16x8*)(SBuf + e_loc * 136 + 32 * ks + 8 * fq);
            aP = mfma16(aw, bS, aP);
            aO = mfma16(aq, bS, aO);
        }
        {
            const bf16x4 u = *(const LAS bf16x4*)(sb + G2_U + (e_loc * 72 + 16 * i + 4 * fq) * 2);
            float uf[4];
            unpack4(u, uf);
            if (MODE == 1) { uf[0] = 0.f; uf[1] = 0.f; uf[2] = 0.f; uf[3] = 0.f; }
            f32x4 vn;
#pragma unroll
            for (int r = 0; r < 4; r++) vn[r] = uf[r] - aP[r];
            *(LAS u32x2*)(VN + e_loc * 72 + 16 * i + 4 * fq) = pack4(vn);
        }
        lds_barrier();
        bf16x8 bV[2];
#pragma unroll
        for (int ks = 0; ks < 2; ks++) bV[ks] = *(const LAS bf16x8*)(VN + e_loc * 72 + 32 * ks + 8 * fq);
#pragma unroll
        for (int ks = 0; ks < 2; ks++) {
            const bf16x8 aa = *(const LAS bf16x8*)(sb + G2_A + ((16 * i + fr) * 72 + 32 * ks + 8 * fq) * 2);
            aO = mfma16(aa, bV[ks], aO);
        }
        {
            const size_t row0 = (size_t)(b * 128 + c) * 64;
            bf16_t* od = PROJ + (row0 + (e >> 1)) * LDP + QKV0 + 2048 + h * 128 + (e & 1) * 64 + 16 * i + 4 * fq;
            if (DRY) od = (bf16_t*)((char*)p->out + 52428800 + (((size_t)((char*)od - (char*)PROJ)) & 0x7ffff8));
            if (MODE == 1) {
                bf16_t* oi = (bf16_t*)((char*)p->out + OUT_OI_OFF) + ((size_t)((c - 64) * 16 + bh) * 64 + 16 * i + 4 * fq) * 128 + es * 32 + e_loc;
#pragma unroll
                for (int r = 0; r < 4; r++) oi[r * 128] = f2bf(aO[r]);
            } else if (DRY == 2) sink += aO[0] + aO[1] + aO[2] + aO[3]; else *(u32x2*)od = pack4(aO);
        }
        const float gl = GL[slot];
        S0 *= gl; S1 *= gl;
#pragma unroll
        for (int ks = 0; ks < 2; ks++) {
            const bf16x8 k0 = *(const LAS bf16x8*)(sb + G2_K + ((16 * dt0 + fr) * 72 + 32 * ks + 8 * fq) * 2);
            const bf16x8 k1 = *(const LAS bf16x8*)(sb + G2_K + ((16 * (dt0 + 1) + fr) * 72 + 32 * ks + 8 * fq) * 2);
            S0 = mfma16(k0, bV[ks], S0);
            S1 = mfma16(k1, bV[ks], S1);
        }
        *(LAS u32x2*)(SBuf + e_loc * 136 + 16 * dt0 + 4 * fq) = pack4(S0);
        *(LAS u32x2*)(SBuf + e_loc * 136 + 16 * (dt0 + 1) + 4 * fq) = pack4(S1);
        lds_barrier();
    };
    for (int c = c0; c < c0 + 64; c += 4) { step(c, R1, R0); step(c + 1, R2, R1); step(c + 2, R3, R2); step(c + 3, R0, R3); }
    if (MODE == 0 && c0 == 0) {
        bf16_t* sd = (bf16_t*)(p->ws + OFF_S64) + ((size_t)bh * 128 + e) * 128 + 4 * fq;
        *(u32x2*)(sd + 16 * dt0) = pack4(S0);
        *(u32x2*)(sd + 16 * (dt0 + 1)) = pack4(S1);
    }
    if (DRY == 2) *(float*)((char*)p->out + 52428800 + (size_t)(blockIdx.x * NTHR + tid) * 4) = sink;
}

constexpr int S2_SLOT0 = 34816, S2_SLOTB = 54784;
constexpr int S2_C = 0, S2_B = 17408, S2_X = 35840, S2_Y = 45056, S2_E = 54272;
struct SsdStage { u32x4 r[6]; float el; };

template <int DRY>
__device__ __forceinline__ void ssd_scan2(PP p, const int bh, const int c0) {
    LAS char* lb = (LAS char*)dsm;
    asm volatile("" : "+v"(lb));
    LAS bf16_t* HT = (LAS bf16_t*)lb;
    const int tid = tid_opaque(), lane = tid & 63, wid = __builtin_amdgcn_readfirstlane(tid >> 6), fr = lane & 15, fq = lane >> 4;
    bf16_t* PROJ = (bf16_t*)(p->ws + OFF_PROJ);
    const float* SMALL = (const float*)(p->ws + OFF_SMALL);
    bf16_t* YPART = (bf16_t*)(p->ws + OFF_YPART);
    const int b = bh >> 4, hh = bh & 15, g = hh >> 3;
    for (int idx = tid; idx < 64 * 136 / 2; idx += NTHR) ((LAS unsigned*)HT)[idx] = 0u;
    const int lr = tid >> 4, c16 = tid & 15, r8 = tid >> 3, c8 = tid & 7;
    const size_t rowb = (size_t)(b * 128) * 64;
    const char* gC = (const char*)PROJ + ((rowb + lr) * LDP + XBC0 + 1280 + g * 128) * 2 + c16 * 16;
    const char* gB = (const char*)PROJ + ((rowb + lr) * LDP + XBC0 + 1024 + g * 128) * 2 + c16 * 16;
    const char* gX = (const char*)PROJ + ((rowb + r8) * LDP + XBC0 + hh * 64) * 2 + c8 * 16;
    const char* gY = (const char*)YPART + ((rowb + r8) * 1024 + hh * 64) * 2 + c8 * 16;
    const float* gE = SMALL + (rowb + (tid & 63)) * 32 + hh;
    const unsigned dC = (unsigned)(lr * 136 + c16 * 8) * 2;
    const unsigned dB = (unsigned)((2 * lr + (c16 >> 3)) * 72 + (c16 & 7) * 8) * 2;
    const unsigned dX = (unsigned)(r8 * 72 + c8 * 8) * 2;
    auto issue = [&](int c, SsdStage& st) {
        c = c > c0 + 63 ? c0 + 63 : c;
        if (DRY == 3) c = 0;
        const size_t co = (size_t)((DRY == 4) ? 0 : c) * 64 * LDP * 2;
#pragma unroll
        for (int j = 0; j < 2; j++) st.r[j] = *(const u32x4*)(gC + co + (size_t)j * 32 * LDP * 2);
#pragma unroll
        for (int j = 0; j < 2; j++) st.r[2 + j] = *(const u32x4*)(gB + co + (size_t)j * 32 * LDP * 2);
        st.r[4] = *(const u32x4*)(gX + co);
        st.r[5] = *(const u32x4*)(gY + (size_t)c * 64 * 2048);
        st.el = gE[(size_t)c * 64 * 32];
    };
    auto commit = [&](const SsdStage& st, int slot) {
        LAS char* sb = lb + S2_SLOT0 + slot * S2_SLOTB;
#pragma unroll
        for (int j = 0; j < 2; j++) *(LAS u32x4*)(sb + S2_C + dC + j * 32 * 272) = st.r[j];
#pragma unroll
        for (int j = 0; j < 2; j++) *(LAS u32x4*)(sb + S2_B + dB + j * 64 * 144) = st.r[2 + j];
        *(LAS u32x4*)(sb + S2_X + dX) = st.r[4];
        *(LAS u32x4*)(sb + S2_Y + dX) = st.r[5];
        if (tid < 64) *(LAS float*)(sb + S2_E + tid * 4) = st.el;
    };
    const int i = wid & 3, ptb = 2 * (wid >> 2);
    f32x4 hs[4];
#pragma unroll
    for (int c = 0; c < 4; c++) hs[c] = (f32x4){0.f, 0.f, 0.f, 0.f};
    float sink = 0.f;
    SsdStage R0, R1, R2, R3;
    issue(c0, R0);
    commit(R0, 0);
    issue(c0 + 1, R1); issue(c0 + 2, R2); issue(c0 + 3, R3);
    float cum = 1.f;
    lds_barrier();
    auto step = [&](const int c, SsdStage& R, SsdStage& RI) {
        const int slot = c & 1;
        LAS char* sb = lb + S2_SLOT0 + slot * S2_SLOTB;
        commit(R, slot ^ 1);
        issue(c + 4, RI);
        const LAS bf16_t* Hc = HT + slot * 8704;
        LAS bf16_t* Hn = HT + (slot ^ 1) * 8704;
        const size_t row0 = (size_t)(b * 128 + c) * 64;
        const float elc = *(const LAS float*)(sb + S2_E + (16 * i + fr) * 4);
        const float dec = *(const LAS float*)(sb + S2_E + 63 * 4);
        if (c0 == 64) { if (tid == 0) ((float*)(p->ws + OFF_CUM))[bh * 64 + (c - 64)] = cum; cum *= dec; }
#pragma unroll
        for (int tt = 0; tt < 2; tt++) {
            const int pt = ptb + tt;
            f32x4 a = {0.f, 0.f, 0.f, 0.f};
#pragma unroll
            for (int ks = 0; ks < 4; ks++) {
                const bf16x8 cB = *(const LAS bf16x8*)(sb + S2_C + ((16 * i + fr) * 136 + 32 * ks + 8 * fq) * 2);
                const bf16x8 hf = *(const LAS bf16x8*)(Hc + (16 * pt + fr) * 136 + 32 * ks + 8 * fq);
                a = mfma16(hf, cB, a);
            }
            const bf16x4 yp = *(const LAS bf16x4*)(sb + S2_Y + ((16 * i + fr) * 72 + 16 * pt + 4 * fq) * 2);
            float yf[4];
            unpack4(yp, yf);
            f32x4 y;
#pragma unroll
            for (int r = 0; r < 4; r++) y[r] = yf[r] + elc * a[r];
            bf16_t* yd = YPART + (row0 + 16 * i + fr) * 1024 + hh * 64 + 16 * pt + 4 * fq;
            if (DRY) yd = (bf16_t*)((char*)p->out + 52428800 + (((size_t)((char*)yd - (char*)YPART)) & 0x7ffff8));
            if (DRY == 2) sink += y[0] + y[1] + y[2] + y[3]; else *(u32x2*)yd = pack4(y);
        }
#pragma unroll
        for (int pt = 0; pt < 4; pt++) {
            hs[pt] *= dec;
#pragma unroll
            for (int ks = 0; ks < 2; ks++) {
                const bf16x8 bA = *(const LAS bf16x8*)(sb + S2_B + ((16 * wid + fr) * 72 + 32 * ks + 8 * fq) * 2);
                const bf16x8 xB = *(const LAS bf16x8*)(sb + S2_X + ((16 * pt + fr) * 72 + 32 * ks + 8 * fq) * 2);
                hs[pt] = mfma16(bA, xB, hs[pt]);
            }
            *(LAS u32x2*)(Hn + (16 * pt + fr) * 136 + 16 * wid + 4 * fq) = pack4(hs[pt]);
        }
        lds_barrier();
    };
    for (int c = c0; c < c0 + 64; c += 4) { step(c, R1, R0); step(c + 1, R2, R1); step(c + 2, R3, R2); step(c + 3, R0, R3); }
    if (c0 == 0) {
        bf16_t* hd = (bf16_t*)(p->ws + OFF_H64) + (size_t)bh * 64 * 128 + 16 * wid + 4 * fq;
#pragma unroll
        for (int pt = 0; pt < 4; pt++) *(u32x2*)(hd + (16 * pt + fr) * 128) = pack4(hs[pt]);
    }
    if (DRY == 2) *(float*)((char*)p->out + 52428800 + (size_t)(blockIdx.x * NTHR + tid) * 4) = sink;
}

template <int DRY>
__device__ __forceinline__ void phase_c(PP p) {
    for (int it = blockIdx.x; it < 256; it += gridDim.x) {
        if (it < 192) {
            const int r = it & 63, role = it >> 6;
            const int bh = (r & 7) + 8 * ((r >> 3) >> 2), es = (r >> 3) & 3;
            if (role == 0) gdn_scan2<DRY, 0>(p, bh, es, 0);
            else if (role == 1) gdn_scan2<DRY, 0>(p, bh, es, 64);
            else gdn_scan2<DRY, 1>(p, bh, es, 64);
        } else {
            const int r = it - 192;
            ssd_scan2<DRY>(p, r & 31, (r >> 5) * 64);
        }
        __syncthreads();
    }
}

template <int DRY>
__device__ __forceinline__ void phase_fix(PP p) {
    const int tid = tid_opaque(), lane = tid & 63, wid = tid >> 6, fr = lane & 15, fq = lane >> 4;
    bf16_t* PROJ = (bf16_t*)(p->ws + OFF_PROJ);
    const float* SMALL = (const float*)(p->ws + OFF_SMALL);
    bf16_t* YPART = (bf16_t*)(p->ws + OFF_YPART);
    struct SF { bf16x8 hA[2][4]; bf16x4 y4[2]; float sc; };
    const int i = wid & 3, ptb = 2 * (wid >> 2);
    for (int gi = blockIdx.x; gi < 256; gi += gridDim.x) {
        const int b = gi >> 7, g = (gi >> 6) & 1, cc = gi & 63;
        const size_t row0 = (size_t)(b * 128 + 64 + cc) * 64;
        const bf16_t* crow = PROJ + (row0 + 16 * i + fr) * LDP + XBC0 + 1280 + g * 128 + 8 * fq;
        bf16x8 cB[4];
#pragma unroll
        for (int ks = 0; ks < 4; ks++) cB[ks] = *(const bf16x8*)(crow + 32 * ks);
        auto sload = [&](int hl, SF& f) {
            const int hh = 8 * g + hl, bh = b * 16 + hh;
            f.sc = SMALL[(row0 + 16 * i + fr) * 32 + hh] * ((const float*)(p->ws + OFF_CUM))[bh * 64 + cc];
#pragma unroll
            for (int tt = 0; tt < 2; tt++) {
                const bf16_t* hp = (const bf16_t*)(p->ws + OFF_H64) + ((size_t)bh * 64 + 16 * (ptb + tt) + fr) * 128 + 8 * fq;
#pragma unroll
                for (int ks = 0; ks < 4; ks++) f.hA[tt][ks] = *(const bf16x8*)(hp + 32 * ks);
                f.y4[tt] = *(const bf16x4*)(YPART + (row0 + 16 * i + fr) * 1024 + hh * 64 + 16 * (ptb + tt) + 4 * fq);
            }
        };
        auto sfinish = [&](int hl, const SF& f) {
            const int hh = 8 * g + hl;
#pragma unroll
            for (int tt = 0; tt < 2; tt++) {
                f32x4 acc = {0.f, 0.f, 0.f, 0.f};
#pragma unroll
                for (int ks = 0; ks < 4; ks++) acc = mfma16(f.hA[tt][ks], cB[ks], acc);
                float yf[4];
                unpack4(f.y4[tt], yf);
                f32x4 y;
#pragma unroll
                for (int r = 0; r < 4; r++) y[r] = yf[r] + f.sc * acc[r];
                *(u32x2*)(YPART + (row0 + 16 * i + fr) * 1024 + hh * 64 + 16 * (ptb + tt) + 4 * fq) = pack4(y);
            }
        };
        SF fa, fb;
        sload(0, fa);
#pragma unroll
        for (int hl = 0; hl < 8; hl += 2) {
            sload(hl + 1, fb);
            sfinish(hl, fa);
            if (hl + 2 < 8) sload(hl + 2, fa);
            sfinish(hl + 1, fb);
        }
    }
}

template <int DRY>
__device__ __forceinline__ void phase_d1(PP p) {
    const int tid = tid_opaque(), lane = tid & 63, wid = tid >> 6;
    bf16_t* PROJ = (bf16_t*)(p->ws + OFF_PROJ);
    const bf16_t* YPART = (const bf16_t*)(p->ws + OFF_YPART);
    {
        LAS bf16_t* YL = (LAS bf16_t*)dsm;
        const float* SMALL = (const float*)(p->ws + OFF_SMALL);
        const int fr = lane & 15, fq = lane >> 4, i4 = wid & 3, ptb = 2 * (wid >> 2);
        struct SF { bf16x8 hA[2][4]; bf16x4 y4[2]; float sc; };
        for (int gi = blockIdx.x; gi < 512; gi += gridDim.x) {
            const int k = gi >> 8, j = gi & 255, b = k, g = j >> 7, c = (j & 127) ^ (k << 6);
            const size_t row0 = (size_t)(b * 128 + c) * 64;
            const bool fix = c >= 64;
            bf16x8 yv[8], zv[8];
#pragma unroll
            for (int t8 = 0; t8 < 8; t8++) {
                const size_t tok = row0 + wid * 8 + t8;
                zv[t8] = *(const bf16x8*)(PROJ + tok * LDP + g * 512 + lane * 8);
                if (!fix) yv[t8] = *(const bf16x8*)(YPART + tok * 1024 + g * 512 + lane * 8);
            }
            if (fix) {
                const int cc = c - 64;
                const bf16_t* crow = PROJ + (row0 + 16 * i4 + fr) * LDP + XBC0 + 1280 + g * 128 + 8 * fq;
                bf16x8 cB[4];
#pragma unroll
                for (int ks = 0; ks < 4; ks++) cB[ks] = *(const bf16x8*)(crow + 32 * ks);
                auto sload = [&](int hl, SF& f) {
                    const int hh = 8 * g + hl, bh = b * 16 + hh;
                    f.sc = SMALL[(row0 + 16 * i4 + fr) * 32 + hh] * ((const float*)(p->ws + OFF_CUM))[bh * 64 + cc];
#pragma unroll
                    for (int tt = 0; tt < 2; tt++) {
                        const bf16_t* hp = (const bf16_t*)(p->ws + OFF_H64) + ((size_t)bh * 64 + 16 * (ptb + tt) + fr) * 128 + 8 * fq;
#pragma unroll
                        for (int ks = 0; ks < 4; ks++) f.hA[tt][ks] = *(const bf16x8*)(hp + 32 * ks);
                        f.y4[tt] = *(const bf16x4*)(YPART + (row0 + 16 * i4 + fr) * 1024 + hh * 64 + 16 * (ptb + tt) + 4 * fq);
                    }
                };
                auto sfinish = [&](int hl, const SF& f) {
#pragma unroll
                    for (int tt = 0; tt < 2; tt++) {
                        f32x4 acc = {0.f, 0.f, 0.f, 0.f};
#pragma unroll
                        for (int ks = 0; ks < 4; ks++) acc = mfma16(f.hA[tt][ks], cB[ks], acc);
                        float yf[4];
                        unpack4(f.y4[tt], yf);
                        f32x4 y;
#pragma unroll
                        for (int r = 0; r < 4; r++) y[r] = yf[r] + f.sc * acc[r];
                        *(LAS u32x2*)(YL + (16 * i4 + fr) * 520 + hl * 64 + 16 * (ptb + tt) + 4 * fq) = pack4(y);
                    }
                };
                SF fa, fb;
                sload(0, fa);
#pragma unroll
                for (int hl = 0; hl < 8; hl += 2) {
                    sload(hl + 1, fb);
                    sfinish(hl, fa);
                    if (hl + 2 < 8) sload(hl + 2, fa);
                    sfinish(hl + 1, fb);
                }
                __syncthreads();
#pragma unroll
                for (int t8 = 0; t8 < 8; t8++) yv[t8] = *(const LAS bf16x8*)(YL + (wid * 8 + t8) * 520 + lane * 8);
            }
            const float4 w0 = *(const float4*)(p->ssd_norm_w + g * 512 + lane * 8), w1 = *(const float4*)(p->ssd_norm_w + g * 512 + lane * 8 + 4);
#pragma unroll
            for (int t8 = 0; t8 < 8; t8++) {
                const size_t tok = row0 + wid * 8 + t8;
                float y[8], z[8], v[8];
                unpack8(yv[t8], y); unpack8(zv[t8], z);
                float ss = 0.f;
#pragma unroll
                for (int i = 0; i < 8; i++) { v[i] = y[i] * silu_f(z[i]); ss += v[i] * v[i]; }
                ss = wave_sum(ss);
                const float rs = rsqrtf(ss * (1.f / 512.f) + 1e-6f);
                v[0] *= rs * w0.x; v[1] *= rs * w0.y; v[2] *= rs * w0.z; v[3] *= rs * w0.w;
                v[4] *= rs * w1.x; v[5] *= rs * w1.y; v[6] *= rs * w1.z; v[7] *= rs * w1.w;
                if (DRY) *(u32x4*)((char*)p->out + (((tok * LDP + XBC0 + g * 512 + lane * 8) * 2) & 0x3fffff0)) = pack8(v);
                else *(u32x4*)(PROJ + tok * LDP + XBC0 + g * 512 + lane * 8) = pack8(v);
            }
            if (fix) __syncthreads();
        }
    }
    LAS float* OT = (LAS float*)dsm;
    struct D1In { bf16x8 a, b; unsigned gg[8]; };
    auto d1load = [&](int it, D1In& in) {
        const int ch = it >> 3, h = it & 7;
        const size_t row0 = (size_t)ch * 64;
        const int e = tid >> 2, lq = tid & 3;
        const bf16_t* src = PROJ + (row0 + (e >> 1)) * LDP + QKV0 + 2048 + h * 128 + (e & 1) * 64 + lq * 16;
        in.a = *(const bf16x8*)src; in.b = *(const bf16x8*)(src + 8);
#pragma unroll
        for (int tk = 0; tk < 8; tk++) in.gg[tk] = *(const unsigned*)(PROJ + (row0 + wid * 8 + tk) * LDP + GATE0 + h * 128 + 2 * lane);
    };
    D1In cur, nxt;
    if ((int)blockIdx.x < 2048) d1load(blockIdx.x, cur);
    nxt = cur;
    const float w0 = p->gdn_norm_w[2 * lane], w1 = p->gdn_norm_w[2 * lane + 1];
    for (int it = blockIdx.x; it < 2048; it += gridDim.x) {
        const int ch = it >> 3, h = it & 7;
        const size_t row0 = (size_t)ch * 64;
        {
            const int e = tid >> 2, lq = tid & 3;
            float fa[8], fb[8];
            unpack8(cur.a, fa); unpack8(cur.b, fb);
#pragma unroll
            for (int t = 0; t < 8; t++) { OT[(lq * 16 + t) * 129 + e] = fa[t]; OT[(lq * 16 + 8 + t) * 129 + e] = fb[t]; }
        }
        const bool fix = (ch & 127) >= 64;
        bf16x8 fS[4], fI[4][4];
        if (fix) {
            const int fr = lane & 15, fq = lane >> 4, bh = (ch >> 7) * 8 + h, cc = (ch & 127) - 64;
            const bf16_t* sp = (const bf16_t*)(p->ws + OFF_S64) + ((size_t)bh * 128 + 16 * wid + fr) * 128 + 8 * fq;
            const bf16_t* oi = (const bf16_t*)((const char*)p->out + OUT_OI_OFF) + ((size_t)(cc * 16 + bh) * 64 + fr) * 128 + 8 * fq;
#pragma unroll
            for (int ks = 0; ks < 4; ks++) fS[ks] = *(const bf16x8*)(sp + 32 * ks);
#pragma unroll
            for (int lt = 0; lt < 4; lt++)
#pragma unroll
                for (int ks = 0; ks < 4; ks++) fI[lt][ks] = *(const bf16x8*)(oi + (size_t)(16 * lt) * 128 + 32 * ks);
        }
        if (it + (int)gridDim.x < 2048) d1load(it + gridDim.x, nxt);
        __syncthreads();
        if (fix) {
            const int fr = lane & 15, fq = lane >> 4;
#pragma unroll
            for (int lt = 0; lt < 4; lt++) {
                f32x4 acc = {0.f, 0.f, 0.f, 0.f};
#pragma unroll
                for (int ks = 0; ks < 4; ks++) acc = mfma16(fI[lt][ks], fS[ks], acc);
#pragma unroll
                for (int r = 0; r < 4; r++) OT[(16 * lt + 4 * fq + r) * 129 + 16 * wid + fr] += acc[r];
            }
            __syncthreads();
        }
#pragma unroll
        for (int tk = 0; tk < 8; tk++) {
            const int l = wid * 8 + tk;
            const float o0 = OT[l * 129 + 2 * lane], o1 = OT[l * 129 + 2 * lane + 1];
            const float ss = wave_sum(o0 * o0 + o1 * o1);
            const float rs = rsqrtf(ss * (1.f / 128.f) + 1e-6f);
            const unsigned gg = cur.gg[tk];
            const float r0 = o0 * rs * w0 * silu_f(bflo(gg)), r1 = o1 * rs * w1 * silu_f(bfhi(gg));
            if (DRY) *(unsigned*)((char*)p->out + ((((row0 + l) * LDP + QKV0 + 2048 + h * 128 + 2 * lane) * 2) & 0x3fffffc)) = pk2(r0, r1);
            else *(unsigned*)(PROJ + (row0 + l) * LDP + QKV0 + 2048 + h * 128 + 2 * lane) = pk2(r0, r1);
        }
        __syncthreads();
        cur = nxt;
    }
}

__device__ __forceinline__ void phase_final(PP p) {
    const int tid = tid_opaque(), lane = tid & 63, wid = tid >> 6;
    for (int r0 = (blockIdx.x * 8 + wid) * 4; r0 < MTOK; r0 += gridDim.x * 32) {
        float4 v[4][4];
#pragma unroll
        for (int rr = 0; rr < 4; rr++) {
            const float4* xr = (const float4*)(p->out + (size_t)(r0 + rr) * DM);
#pragma unroll
            for (int i = 0; i < 4; i++) v[rr][i] = xr[lane + 64 * i];
        }
#pragma unroll
        for (int rr = 0; rr < 4; rr++) {
            float4* xr = (float4*)(p->out + (size_t)(r0 + rr) * DM);
            float ss = 0.f;
#pragma unroll
            for (int i = 0; i < 4; i++) ss += v[rr][i].x * v[rr][i].x + v[rr][i].y * v[rr][i].y + v[rr][i].z * v[rr][i].z + v[rr][i].w * v[rr][i].w;
            ss = wave_sum(ss);
            const float rs = rsqrtf(ss * (1.f / DM) + 1e-6f);
#pragma unroll
            for (int i = 0; i < 4; i++) {
                const float4 w = ((const float4*)p->final_norm_w)[lane + 64 * i];
                xr[lane + 64 * i] = make_float4(v[rr][i].x * rs * w.x, v[rr][i].y * rs * w.y, v[rr][i].z * rs * w.z, v[rr][i].w * rs * w.w);
            }
        }
    }
}

#define LAUNDER asm volatile("" : "+s"(p))
#ifndef PROG
#define PROG {0, 1, 2, 3, 4, 5}
#endif
constexpr int kProg[] = PROG;
constexpr int kProgLen = sizeof(kProg) / sizeof(int);

template <int PH>
__device__ __forceinline__ void run_phase(PP p, unsigned& bk) {
    if constexpr (PH == 0) phase_prep(p, true);
    else if constexpr (PH == 20) phase_prep(p, false);
    else if constexpr (PH == 1) phase_gemm<1>(p, bk);
    else if constexpr (PH == 2) phase_b<0>(p);
    else if constexpr (PH == 15) { }
    else if constexpr (PH == 12) phase_b<12>(p);
    else if constexpr (PH == 13) phase_b<13>(p);
    else if constexpr (PH == 14) phase_b<14>(p);
    else if constexpr (PH == 17) phase_b<17>(p);
    else if constexpr (PH == 18) phase_b<18>(p);
    else if constexpr (PH == 3) phase_c<0>(p);
    else if constexpr (PH == 7) phase_c<1>(p);
    else if constexpr (PH == 8) phase_c<2>(p);
    else if constexpr (PH == 9) phase_c<3>(p);
    else if constexpr (PH == 10) phase_c<4>(p);
    else if constexpr (PH == 11) phase_c<5>(p);
    else if constexpr (PH == 24) phase_fix<0>(p);
    else if constexpr (PH == 4) phase_d1<0>(p);
    else if constexpr (PH == 16) phase_d1<1>(p);
    else if constexpr (PH == 5) phase_gemm<2>(p, bk);
    else phase_final(p);
}
template <int I>
__device__ __forceinline__ void run_prog(PP p, cg::grid_group& grid, unsigned& bk) {
    if constexpr (I < kProgLen) {
        if (I > 0) {
            if ((gridDim.x & 7u) == 0u) fast_grid_barrier((unsigned*)(p->ws + OFF_BAR), bk);
            else grid.sync();
        }
        LAUNDER;
        run_phase<kProg[I]>(p, bk);
        run_prog<I + 1>(p, grid, bk);
    }
}

template <int LO, int HI>
__global__ void __launch_bounds__(512) hybrid_mega(Params p_arg) {
    cg::grid_group grid = cg::this_grid();
    PP p = (PP)__builtin_amdgcn_kernarg_segment_ptr();
    unsigned bk = 0u;
    if constexpr (LO == 0 && HI == 6) run_prog<0>(p, grid, bk);
    else { LAUNDER; run_phase<LO>(p, bk); }
}

template <int PH>
static void launch_one(const Params& p, int grid_blocks, hipStream_t stream) {
    hipFuncSetAttribute((const void*)hybrid_mega<PH, PH>, hipFuncAttributeMaxDynamicSharedMemorySize, LDS_BYTES);
    hipLaunchKernelGGL((hybrid_mega<PH, PH>), dim3(grid_blocks), dim3(NTHR), LDS_BYTES, stream, p);
}

extern "C" void kernel_launch(void* const* d_in, const int* in_sizes, int n_in, void* d_out, int out_size, void* d_ws, size_t ws_size,
                              hipStream_t stream) {
    static int grid_blocks = 0;
    if (grid_blocks == 0) {
        int dev = 0, cus = 0, per_cu = 0;
        (void)hipGetDevice(&dev);
        (void)hipDeviceGetAttribute(&cus, hipDeviceAttributeMultiprocessorCount, dev);
#if N_LAUNCH_MODE == 1
        (void)hipFuncSetAttribute((const void*)hybrid_mega<0, 6>, hipFuncAttributeMaxDynamicSharedMemorySize, LDS_BYTES);
        (void)hipOccupancyMaxActiveBlocksPerMultiprocessor(&per_cu, (const void*)hybrid_mega<0, 6>, NTHR, LDS_BYTES);
#else
        per_cu = 1;
#endif
        if (per_cu < 1) { fprintf(stderr, "occupancy query returned %d\n", per_cu); per_cu = 1; }
        if (per_cu > 1) per_cu = 1;
        grid_blocks = cus * per_cu;
        if (ws_size < WS_NEED) fprintf(stderr, "workspace too small: %zu < %zu\n", ws_size, (size_t)WS_NEED);
    }
    Params p{};
    p.x = (const float*)d_in[0]; p.norm_w = (const float*)d_in[1]; p.w_in = (const float*)d_in[2];
    p.ssd_conv_w = (const float*)d_in[3]; p.ssd_conv_b = (const float*)d_in[4]; p.ssd_dt_bias = (const float*)d_in[5];
    p.ssd_a_log = (const float*)d_in[6]; p.ssd_d = (const float*)d_in[7]; p.ssd_norm_w = (const float*)d_in[8];
    p.gdn_conv_w = (const float*)d_in[9]; p.gdn_dt_bias = (const float*)d_in[10]; p.gdn_a_log = (const float*)d_in[11];
    p.gdn_norm_w = (const float*)d_in[12]; p.w_out = (const float*)d_in[13]; p.final_norm_w = (const float*)d_in[14];
    p.out = (float*)d_out; p.ws = (char*)d_ws;
#if N_LAUNCH_MODE == 1
    (void)hipMemsetAsync((char*)d_ws + OFF_BAR, 0, BAR_BYTES, stream);
    void* args[] = {&p};
    hipError_t e = hipLaunchCooperativeKernel((const void*)hybrid_mega<0, 6>, dim3(grid_blocks), dim3(NTHR), args, LDS_BYTES, stream);
    if (e != hipSuccess) fprintf(stderr, "cooperative launch failed: %s (grid %d)\n", hipGetErrorString(e), grid_blocks);
#else
    launch_one<0>(p, grid_blocks, stream); launch_one<1>(p, grid_blocks, stream);
    launch_one<2>(p, grid_blocks, stream);
#ifndef SKIP_MID
    launch_one<3>(p, grid_blocks, stream);
#endif
    launch_one<4>(p, grid_blocks, stream);
    launch_one<5>(p, grid_blocks, stream);
    launch_one<6>(p, grid_blocks, stream);
#endif
}
```

```cpp
#include <hip/hip_runtime.h>
#include <hip/hip_cooperative_groups.h>
#include <cstdio>
namespace cg = cooperative_groups;

typedef unsigned short bf16_t;
typedef short bf16x8 __attribute__((ext_vector_type(8)));
typedef short bf16x4 __attribute__((ext_vector_type(4)));
typedef float f32x4 __attribute__((ext_vector_type(4)));
typedef unsigned u32x4 __attribute__((ext_vector_type(4)));
typedef unsigned u32x2 __attribute__((ext_vector_type(2)));

#ifndef N_LAUNCH_MODE
#define N_LAUNCH_MODE 1
#endif

constexpr int NTHR = 512;
constexpr int MTOK = 16384, DM = 1024, LDP = 6656;
constexpr int XBC0 = 1024, GATE0 = 2560, QKV0 = 3584;
constexpr size_t OFF_PROJ = 0;
constexpr size_t OFF_SMALL = OFF_PROJ + (size_t)MTOK * LDP * 2;
constexpr size_t OFF_HALO = OFF_SMALL + (size_t)MTOK * 32 * 4;
constexpr size_t OFF_WOUT = OFF_HALO + (size_t)256 * 3 * 4608 * 2;
constexpr size_t OFF_WIN = OFF_WOUT + (size_t)1024 * 2048 * 2;
constexpr size_t OFF_YPART = OFF_WIN;
constexpr size_t OFF_BAR = OFF_YPART + (size_t)MTOK * 1024 * 2;
constexpr int BAR_BYTES = (19 + 64) * 256;
constexpr size_t OFF_ROWSS = OFF_BAR + BAR_BYTES;
constexpr size_t OFF_S64 = OFF_ROWSS + (size_t)4 * MTOK * 4;
constexpr size_t OFF_H64 = OFF_S64 + (size_t)16 * 128 * 128 * 2;
constexpr size_t OFF_CUM = OFF_H64 + (size_t)32 * 64 * 128 * 2;
constexpr size_t WS_NEED = OFF_CUM + (size_t)32 * 64 * 4;
constexpr size_t OUT_OI_OFF = 50331648;
constexpr size_t OUT_ATTN_OFF = 33554432;
constexpr int LDS_BYTES = 147968;

struct Params {
    const float *x, *norm_w, *w_in, *ssd_conv_w, *ssd_conv_b, *ssd_dt_bias, *ssd_a_log, *ssd_d, *ssd_norm_w,
        *gdn_conv_w, *gdn_dt_bias, *gdn_a_log, *gdn_norm_w, *w_out, *final_norm_w;
    float* out;
    char* ws;
};

#define LAS __attribute__((address_space(3)))
typedef const __attribute__((address_space(4))) Params* PP;

extern __shared__ __attribute__((aligned(16))) char dsm[];

typedef float f32x2 __attribute__((ext_vector_type(2)));
typedef __bf16 bf16x2v __attribute__((ext_vector_type(2)));
__device__ __forceinline__ unsigned pk2(float lo, float hi) {
    const f32x2 v = {lo, hi};
    const bf16x2v b = __builtin_convertvector(v, bf16x2v);
    return __builtin_bit_cast(unsigned, b);
}
__device__ __forceinline__ bf16_t f2bf(float f) { return (bf16_t)(pk2(f, 0.f) & 0xffffu); }
__device__ __forceinline__ float bf2f(bf16_t h) { return __uint_as_float(((unsigned)h) << 16); }
__device__ __forceinline__ float bflo(unsigned u) { return __uint_as_float(u << 16); }
__device__ __forceinline__ float bfhi(unsigned u) { return __uint_as_float(u & 0xffff0000u); }
__device__ __forceinline__ void unpack8(const bf16x8& v, float* f) {
    u32x4 u = __builtin_bit_cast(u32x4, v);
#pragma unroll
    for (int i = 0; i < 4; i++) { f[2 * i] = bflo(u[i]); f[2 * i + 1] = bfhi(u[i]); }
}
__device__ __forceinline__ void unpack4(const bf16x4& v, float* f) {
    u32x2 u = __builtin_bit_cast(u32x2, v);
    f[0] = bflo(u[0]); f[1] = bfhi(u[0]); f[2] = bflo(u[1]); f[3] = bfhi(u[1]);
}
__device__ __forceinline__ u32x4 pack8(const float* f) {
    u32x4 o; o[0] = pk2(f[0], f[1]); o[1] = pk2(f[2], f[3]); o[2] = pk2(f[4], f[5]); o[3] = pk2(f[6], f[7]);
    return o;
}
__device__ __forceinline__ u32x2 pack4(const f32x4& v) {
    u32x2 o; o[0] = pk2(v[0], v[1]); o[1] = pk2(v[2], v[3]);
    return o;
}
__device__ __forceinline__ float wave_sum(float v) {
#pragma unroll
    for (int o = 32; o > 0; o >>= 1) v += __shfl_xor(v, o, 64);
    return v;
}
__device__ __forceinline__ float wave_incl_scan(float v, int lane) {
#pragma unroll
    for (int o = 1; o < 64; o <<= 1) { float t = __shfl_up(v, o, 64); if (lane >= o) v += t; }
    return v;
}
__device__ __forceinline__ float softplus_f(float x) { return x > 20.f ? x : log1pf(expf(x)); }
__device__ __forceinline__ float silu_f(float x) { return x * __builtin_amdgcn_rcpf(1.f + __expf(-x)); }
__device__ __forceinline__ f32x4 mfma16(const bf16x8& a, const bf16x8& b, const f32x4& c) {
    return __builtin_amdgcn_mfma_f32_16x16x32_bf16(a, b, c, 0, 0, 0);
}
__device__ __forceinline__ int tid_opaque() {
    int t = threadIdx.x;
    asm volatile("" : "+v"(t));
    return t;
}
__device__ __forceinline__ unsigned gb_ld(unsigned* q) { return __hip_atomic_load(q, __ATOMIC_RELAXED, __HIP_MEMORY_SCOPE_AGENT); }
__device__ __forceinline__ unsigned gb_add(unsigned* q) { return __hip_atomic_fetch_add(q, 1u, __ATOMIC_RELAXED, __HIP_MEMORY_SCOPE_AGENT); }
__device__ __forceinline__ void fast_grid_barrier(unsigned* bw, unsigned& k) {
    asm volatile("s_waitcnt vmcnt(0)" ::: "memory");
    __syncthreads();
    if (threadIdx.x == 0) {
        const unsigned G = gridDim.x, g = blockIdx.x & 7u;
        const unsigned nloc = (G - g + 7u) >> 3, ngrp = G < 8u ? G : 8u;
        __builtin_amdgcn_fence(__ATOMIC_RELEASE, "agent");
        asm volatile("s_waitcnt vmcnt(0)" ::: "memory");
        unsigned* sub = bw + 64 * (1 + g);
        unsigned* gen = bw + 64 * (9 + g);
        unsigned* top = bw + 64 * 17;
        unsigned* topgen = bw + 64 * 18;
        const unsigned old = gb_add(sub);
        if (old + 1u == (k + 1u) * nloc) {
            const unsigned og = gb_add(top);
            if (og + 1u == (k + 1u) * ngrp) gb_add(topgen);
            else while (gb_ld(topgen) == k) __builtin_amdgcn_s_sleep(1);
            gb_add(gen);
        } else {
            while (gb_ld(gen) == k) __builtin_amdgcn_s_sleep(1);
        }
        __builtin_amdgcn_fence(__ATOMIC_ACQUIRE, "agent");
        asm volatile("s_waitcnt vmcnt(0)" ::: "memory");
    }
    __syncthreads();
    k++;
}
__device__ __forceinline__ void lds_barrier() {
    asm volatile("s_waitcnt lgkmcnt(0)" ::: "memory");
    __builtin_amdgcn_s_barrier();
    asm volatile("" ::: "memory");
}

__device__ __forceinline__ int src_col(int n) {
    if (n < 2560) return n;
    if (n < 6656) return n + 16;
    if (n < 6672) return n - 6656 + 2560;
    if (n < 6688) return n;
    return -1;
}

__device__ __forceinline__ void phase_prep(PP p, const bool zero_bar) {
    LAS float* tile = (LAS float*)dsm;
    const int tid = tid_opaque(), lane = tid & 63, wid = tid >> 6;
    bf16_t* U = (bf16_t*)p->out;
    for (int r0 = (blockIdx.x * 8 + wid) * 4; r0 < MTOK; r0 += gridDim.x * 32) {
        float4 v[4][4];
#pragma unroll
        for (int rr = 0; rr < 4; rr++) {
            const float4* xr = (const float4*)(p->x + (size_t)(r0 + rr) * DM);
#pragma unroll
            for (int i = 0; i < 4; i++) v[rr][i] = xr[lane + 64 * i];
        }
#pragma unroll
        for (int rr = 0; rr < 4; rr++) {
            float ss = 0.f;
#pragma unroll
            for (int i = 0; i < 4; i++) ss += v[rr][i].x * v[rr][i].x + v[rr][i].y * v[rr][i].y + v[rr][i].z * v[rr][i].z + v[rr][i].w * v[rr][i].w;
            ss = wave_sum(ss);
            const float rs = rsqrtf(ss * (1.f / DM) + 1e-6f);
#pragma unroll
            for (int i = 0; i < 4; i++) {
                const float4 w = ((const float4*)p->norm_w)[lane + 64 * i];
                u32x2 o;
                o[0] = pk2(v[rr][i].x * rs * w.x, v[rr][i].y * rs * w.y);
                o[1] = pk2(v[rr][i].z * rs * w.z, v[rr][i].w * rs * w.w);
                *(u32x2*)(U + (size_t)(r0 + rr) * DM + (lane + 64 * i) * 4) = o;
            }
        }
    }
    bf16_t* WIN = (bf16_t*)(p->ws + OFF_WIN);
    bf16_t* WOUT = (bf16_t*)(p->ws + OFF_WOUT);
    auto tload = [&](int t, float (&val)[8]) {
        const bool isin = t < 1728;
        const int tt = isin ? t : t - 1728;
        const int ntile = isin ? tt / 16 : tt / 32, ktile = isin ? tt % 16 : tt % 32;
        const float* src = isin ? p->w_in : p->w_out;
        const int ld = isin ? 6688 : 1024;
#pragma unroll
        for (int it = 0; it < 8; it++) {
            const int e = tid + it * 512, r = e >> 6, c = e & 63, n = ntile * 64 + c;
            const int sc = isin ? src_col(n) : n;
            val[it] = 0.f;
            if (sc >= 0) val[it] = src[(size_t)(ktile * 64 + r) * ld + sc];
        }
    };
    float cur[8], nxt[8];
#pragma unroll
    for (int it = 0; it < 8; it++) { cur[it] = 0.f; nxt[it] = 0.f; }
    if (blockIdx.x < 1728 + 512) tload(blockIdx.x, cur);
    for (int t = blockIdx.x; t < 1728 + 512; t += gridDim.x) {
        const bool isin = t < 1728;
        const int tt = isin ? t : t - 1728;
        const int ntile = isin ? tt / 16 : tt / 32, ktile = isin ? tt % 16 : tt % 32;
        const int K = isin ? 1024 : 2048;
        bf16_t* dst = isin ? WIN : WOUT;
#pragma unroll
        for (int it = 0; it < 8; it++) {
            const int e = tid + it * 512, r = e >> 6, c = e & 63;
            tile[r * 65 + c] = cur[it];
        }
        if (t + (int)gridDim.x < 1728 + 512) tload(t + gridDim.x, nxt);
        __syncthreads();
        {
            const int c = tid >> 3, r0 = (tid & 7) * 8;
            float f[8];
#pragma unroll
            for (int i = 0; i < 8; i++) f[i] = tile[(r0 + i) * 65 + c];
            *(u32x4*)(dst + (size_t)(ntile * 64 + c) * K + ktile * 64 + r0) = pack8(f);
        }
        __syncthreads();
#pragma unroll
        for (int it = 0; it < 8; it++) cur[it] = nxt[it];
    }
}

constexpr int HT_ELEMS = 128 * 64;
__device__ __forceinline__ int lds_byte(int r, int c) {
    int st = (r >> 4) * 2 + (c >> 5), rr = r & 15, cc = c & 31, ob = rr * 64 + cc * 2;
    return st * 1024 + (ob ^ (((ob >> 9) & 1) << 5));
}
__device__ __forceinline__ int perm32(int rho) { const int n = rho >> 4, i = rho & 15; return 8 * (i >> 2) + 4 * n + (i & 3); }
__device__ __forceinline__ void stage_rc(int b, int& R, int& C) {
    int st = b / 1024, sb = b % 1024, swz = sb ^ (((sb >> 9) & 1) << 5);
    R = (st >> 1) * 16 + swz / 64;
    C = (st & 1) * 32 + (swz % 64) / 2;
}

template <int GID>
__device__ __forceinline__ void gemm_tile(PP p, const int tid, const int brow, const int bcol) {
    constexpr int K = (GID == 1) ? 1024 : 2048;
    constexpr int LDA = (GID == 1) ? 1024 : LDP;
    constexpr int HALF = 128;
    constexpr int HTB = 128 * 64 * 2;
    LAS unsigned char* lds = (LAS unsigned char*)dsm;
    const int wid = __builtin_amdgcn_readfirstlane(tid >> 6), lane = tid & 63, wr = wid >> 2, wc = wid & 3, fr = lane & 15, fq = lane >> 4;
    unsigned voffA[2], voffB[2];
#pragma unroll
    for (int i = 0; i < 2; ++i) {
        int R, C; stage_rc(tid * 16 + i * 8192, R, C);
        const int Rb = (R & ~31) + perm32(R & 31);
        voffA[i] = (unsigned)(R * LDA + C) * 2u; voffB[i] = (unsigned)(Rb * K + C) * 2u;
    }
    const char* Abase = (GID == 1) ? (const char*)p->out : (const char*)(p->ws + OFF_PROJ);
    const char* cA = Abase + (size_t)brow * LDA * 2;
    const char* cB = (const char*)(p->ws + (GID == 1 ? OFF_WIN : OFF_WOUT)) + (size_t)bcol * K * 2;
    constexpr size_t hstepA = (size_t)HALF * LDA * 2, hstepB = (size_t)HALF * K * 2;
    const unsigned ldsw = (unsigned)wid * 1024u;
    const int aoff = lds_byte(wr * 64 + fr, fq * 8), boff = lds_byte(wc * 32 + fr, fq * 8);
#define AKOFF(kt) ((GID == 1) ? (size_t)(kt) * 128 : ((kt) < 16 ? (size_t)(1024 + (kt) * 64) * 2 : (size_t)(5632 + ((kt) - 16) * 64) * 2))
#define BKOFF(kt) ((size_t)(kt) * 128)
#define SA(b, h) (((b) * 2 + (h)) * HTB)
#define SB(b, h) ((4 + (b) * 2 + (h)) * HTB)
#define STAGE(bufoff, gbase, voff)                                                                                  \
    do {                                                                                                           \
        _Pragma("unroll") for (int _i = 0; _i < 2; ++_i)                                                           \
            __builtin_amdgcn_global_load_lds((const unsigned*)((const char*)(gbase) + (voff)[_i]),                  \
                                             (LAS unsigned*)(lds + (bufoff) + ldsw + _i * 8192), 16, 0, 0);        \
    } while (0)
#define LDA_(dst, b, h)                                                                                             \
    do {                                                                                                           \
        _Pragma("unroll") for (int m = 0; m < 4; ++m) _Pragma("unroll") for (int k = 0; k < 2; ++k)                \
            dst[m][k] = *(const LAS bf16x8*)(lds + SA(b, h) + aoff + m * 2048 + k * 1024);                         \
    } while (0)
#define LDB_(dst, b, h)                                                                                             \
    do {                                                                                                           \
        _Pragma("unroll") for (int n = 0; n < 2; ++n) _Pragma("unroll") for (int k = 0; k < 2; ++k)                \
            dst[n][k] = *(const LAS bf16x8*)(lds + SB(b, h) + boff + n * 2048 + k * 1024);                         \
    } while (0)
#define MMA(ai, bj, At_, Bt_)                                                                                       \
    do {                                                                                                           \
        __builtin_amdgcn_s_setprio(1);                                                                             \
        _Pragma("unroll") for (int m = 0; m < 4; ++m) _Pragma("unroll") for (int n = 0; n < 2; ++n)                \
            _Pragma("unroll") for (int k = 0; k < 2; ++k)                                                          \
                acc[ai][bj][m][n] = __builtin_amdgcn_mfma_f32_16x16x32_bf16(Bt_[n][k], At_[m][k], acc[ai][bj][m][n], 0, 0, 0); \
        __builtin_amdgcn_s_setprio(0);                                                                             \
    } while (0)
#define WAIT_V(n) asm volatile("s_waitcnt vmcnt(" #n ")" ::: "memory")
#define WAIT_L(n) asm volatile("s_waitcnt lgkmcnt(" #n ")" ::: "memory")
#define BAR __builtin_amdgcn_s_barrier()
#define SCHED __builtin_amdgcn_sched_barrier(0)

    f32x4 acc[2][2][4][2];
#pragma unroll
    for (int a = 0; a < 2; ++a)
#pragma unroll
        for (int b = 0; b < 2; ++b)
#pragma unroll
            for (int m = 0; m < 4; ++m)
#pragma unroll
                for (int n = 0; n < 2; ++n) acc[a][b][m][n] = (f32x4){0.f, 0.f, 0.f, 0.f};
    bf16x8 At[4][2], B0[2][2], B1[2][2];
    constexpr int nt = K / 64;
    STAGE(SB(0, 0), cB + BKOFF(0), voffB); STAGE(SA(0, 0), cA + AKOFF(0), voffA);
    STAGE(SB(0, 1), cB + hstepB + BKOFF(0), voffB); STAGE(SA(0, 1), cA + hstepA + AKOFF(0), voffA);
    if (wr == 1) BAR;
    WAIT_V(4); BAR;
    STAGE(SB(1, 0), cB + BKOFF(1), voffB); STAGE(SA(1, 0), cA + AKOFF(1), voffA); STAGE(SB(1, 1), cB + hstepB + BKOFF(1), voffB);
    WAIT_V(6); BAR;
    for (int t = 0; t < nt - 2; t += 2) {
        LDB_(B0, 0, 0); SCHED; LDA_(At, 0, 0); STAGE(SA(1, 1), cA + hstepA + AKOFF(t + 1), voffA);
        WAIT_L(8); BAR; WAIT_L(0); MMA(0, 0, At, B0); BAR; SCHED;
        LDB_(B1, 0, 1); STAGE(SB(0, 0), cB + BKOFF(t + 2), voffB);
        BAR; WAIT_L(0); MMA(0, 1, At, B1); BAR;
        LDA_(At, 0, 1); STAGE(SA(0, 0), cA + AKOFF(t + 2), voffA);
        BAR; WAIT_L(0); MMA(1, 0, At, B0); BAR; SCHED;
        STAGE(SB(0, 1), cB + hstepB + BKOFF(t + 2), voffB);
        WAIT_V(6); BAR; MMA(1, 1, At, B1); BAR;
        LDB_(B0, 1, 0); SCHED; LDA_(At, 1, 0); STAGE(SA(0, 1), cA + hstepA + AKOFF(t + 2), voffA);
        WAIT_L(8); BAR; WAIT_L(0); MMA(0, 0, At, B0); BAR; SCHED;
        LDB_(B1, 1, 1); STAGE(SB(1, 0), cB + BKOFF(t + 3), voffB);
        BAR; WAIT_L(0); MMA(0, 1, At, B1); BAR;
        LDA_(At, 1, 1); STAGE(SA(1, 0), cA + AKOFF(t + 3), voffA);
        BAR; WAIT_L(0); MMA(1, 0, At, B0); BAR; SCHED;
        STAGE(SB(1, 1), cB + hstepB + BKOFF(t + 3), voffB);
        WAIT_V(6); BAR; MMA(1, 1, At, B1); BAR;
    }
    {
        LDB_(B0, 0, 0); LDA_(At, 0, 0); STAGE(SA(1, 1), cA + hstepA + AKOFF(nt - 1), voffA);
        BAR; WAIT_L(0); MMA(0, 0, At, B0); BAR;
        LDB_(B1, 0, 1); BAR; WAIT_L(0); MMA(0, 1, At, B1); BAR;
        LDA_(At, 0, 1); WAIT_V(4); BAR; WAIT_L(0); MMA(1, 0, At, B0); MMA(1, 1, At, B1); BAR;
    }
    {
        LDB_(B0, 1, 0); LDA_(At, 1, 0); WAIT_V(2); BAR; WAIT_L(0); MMA(0, 0, At, B0); BAR;
        LDB_(B1, 1, 1); WAIT_V(0); BAR; WAIT_L(0); MMA(0, 1, At, B1); BAR;
        LDA_(At, 1, 1); BAR; WAIT_L(0); MMA(1, 0, At, B0); MMA(1, 1, At, B1); BAR;
    }
    if (wr == 0) BAR;
    if (GID == 1) {
        if (bcol < 6656) {
            bf16_t* dst0 = (bf16_t*)(p->ws + OFF_PROJ) + (size_t)(brow + wr * 64 + fr) * LDP + bcol + wc * 32 + fq * 4;
#pragma unroll
            for (int ai = 0; ai < 2; ++ai)
#pragma unroll
                for (int m = 0; m < 4; ++m)
#pragma unroll
                    for (int bj = 0; bj < 2; ++bj)
#pragma unroll
                        for (int n = 0; n < 2; ++n)
                            *(u32x2*)(dst0 + (size_t)(ai * HALF + m * 16) * LDP + bj * HALF + n * 16) = pack4(acc[ai][bj][m][n]);
            const int hcb = (bcol >= 3584) ? (bcol - 3584 + 1536) : ((bcol >= 1024 && bcol < 2560) ? (bcol - 1024) : -1);
            if (hcb >= 0 && fr >= 13) {
#pragma unroll
                for (int ai = 0; ai < 2; ++ai) {
                    const int row = brow + ai * HALF + wr * 64 + 48 + fr;
                    bf16_t* hd = (bf16_t*)(p->ws + OFF_HALO) + ((size_t)(row >> 6) * 3 + (fr - 13)) * 4608 + hcb + wc * 32 + fq * 4;
#pragma unroll
                    for (int bj = 0; bj < 2; ++bj)
#pragma unroll
                        for (int n = 0; n < 2; ++n) *(u32x2*)(hd + bj * HALF + n * 16) = pack4(acc[ai][bj][3][n]);
                }
            }
        } else if (wc == 0) {
            float* sd = (float*)(p->ws + OFF_SMALL) + (size_t)(brow + wr * 64 + fr) * 32 + fq * 4;
#pragma unroll
            for (int ai = 0; ai < 2; ++ai)
#pragma unroll
                for (int m = 0; m < 4; ++m)
#pragma unroll
                    for (int n = 0; n < 2; ++n) *(f32x4*)(sd + (size_t)(ai * HALF + m * 16) * 32 + n * 16) = acc[ai][0][m][n];
        }
    } else {
#pragma unroll
        for (int ai = 0; ai < 2; ++ai)
#pragma unroll
            for (int m = 0; m < 4; ++m) {
                const int row = brow + ai * HALF + wr * 64 + m * 16 + fr;
#pragma unroll
                for (int bj = 0; bj < 2; ++bj)
#pragma unroll
                    for (int n = 0; n < 2; ++n) {
                        const int col = bcol + bj * HALF + wc * 32 + fq * 8 + n * 4;
                        const f32x4 xv = *(const f32x4*)(p->x + (size_t)row * DM + col);
                        *(f32x4*)(p->out + (size_t)row * DM + col) = xv + acc[ai][bj][m][n];
                    }
            }
    }
#undef SA
#undef SB
#undef STAGE
#undef LDA_
#undef LDB_
#undef MMA
#undef AKOFF
#undef BKOFF
}


template <int GID>
__device__ __forceinline__ bool gemm_unit(int i, int& pm, int& pn) {
    constexpr int nM = 64, nN = (GID == 1) ? 27 : 4, nwg = nM * nN;
    const long L = (long)i * gridDim.x + blockIdx.x;
    if (L >= nwg) return false;
    int wgid = (int)L;
    {
        const int q = nwg / 8, r = nwg % 8, xcd = wgid % 8, off = wgid / 8;
        wgid = (xcd < r ? xcd * (q + 1) : r * (q + 1) + (xcd - r) * q) + off;
    }
    const int nig = 8 * nN, gid = wgid / nig, fm = gid * 8, gsz = (nM - fm) < 8 ? (nM - fm) : 8;
    pm = fm + ((wgid % nig) % gsz);
    pn = (wgid % nig) / gsz;
    return true;
}

template <int GID>
__device__ __forceinline__ void phase_gemm(PP p, unsigned& bk) {
    constexpr int K = (GID == 1) ? 1024 : 2048;
    constexpr int LDA = (GID == 1) ? 1024 : LDP;
    constexpr int HALF = 128;
    constexpr int HTB = 128 * 64 * 2;
    constexpr int nt = K / 64;
    int pm, pn;
    if (!gemm_unit<GID>(0, pm, pn)) {
        if (GID == 2) fast_grid_barrier((unsigned*)(p->ws + OFF_BAR), bk);
        return;
    }
    LAS unsigned char* lds = (LAS unsigned char*)dsm;
    int tid = threadIdx.x;
    asm volatile("" : "+v"(tid));
    const int wid = __builtin_amdgcn_readfirstlane(tid >> 6), lane = tid & 63, wr = wid >> 2, wc = wid & 3, fr = lane & 15, fq = lane >> 4;
    unsigned voffA[2], voffB[2];
#pragma unroll
    for (int i = 0; i < 2; ++i) {
        int R, C; stage_rc(tid * 16 + i * 8192, R, C);
        const int Rb = (R & ~31) + perm32(R & 31);
        voffA[i] = (unsigned)(R * LDA + C) * 2u; voffB[i] = (unsigned)(Rb * K + C) * 2u;
    }
    const char* Abase = (GID == 1) ? (const char*)p->out : (const char*)(p->ws + OFF_PROJ);
    const char* Bbase = (const char*)(p->ws + (GID == 1 ? OFF_WIN : OFF_WOUT));
    constexpr size_t hstepA = (size_t)HALF * LDA * 2, hstepB = (size_t)HALF * K * 2;
    constexpr size_t tstepA = 2 * hstepA, tstepB = 2 * hstepB;
    const unsigned ldsw = (unsigned)wid * 1024u;
    const int aoff = lds_byte(wr * 64 + fr, fq * 8), boff = lds_byte(wc * 32 + fr, fq * 8);
#define AKOFF(kt) ((GID == 1) ? (size_t)(kt) * 128 : ((kt) < 16 ? (size_t)(1024 + (kt) * 64) * 2 : (size_t)(5632 + ((kt) - 16) * 64) * 2))
#define BKOFF(kt) ((size_t)(kt) * 128)
#define SA(b, h) (((b) * 2 + (h)) * HTB)
#define SB(b, h) ((4 + (b) * 2 + (h)) * HTB)
#define STAGE(bufoff, gbase, voff)                                                                                  \
    do {                                                                                                           \
        _Pragma("unroll") for (int _i = 0; _i < 2; ++_i)                                                           \
            __builtin_amdgcn_global_load_lds((const unsigned*)((const char*)(gbase) + (voff)[_i]),                  \
                                             (LAS unsigned*)(lds + (bufoff) + ldsw + _i * 8192), 16, 0, 0);        \
    } while (0)
#define LDA_(dst, b, h)                                                                                             \
    do {                                                                                                           \
        _Pragma("unroll") for (int m = 0; m < 4; ++m) _Pragma("unroll") for (int k = 0; k < 2; ++k)                \
            dst[m][k] = *(const LAS bf16x8*)(lds + SA(b, h) + aoff + m * 2048 + k * 1024);                         \
    } while (0)
#define LDB_(dst, b, h)                                                                                             \
    do {                                                                                                           \
        _Pragma("unroll") for (int n = 0; n < 2; ++n) _Pragma("unroll") for (int k = 0; k < 2; ++k)                \
            dst[n][k] = *(const LAS bf16x8*)(lds + SB(b, h) + boff + n * 2048 + k * 1024);                         \
    } while (0)
#define MMA(ai, bj, At_, Bt_)                                                                                       \
    do {                                                                                                           \
        __builtin_amdgcn_s_setprio(1);                                                                             \
        _Pragma("unroll") for (int m = 0; m < 4; ++m) _Pragma("unroll") for (int n = 0; n < 2; ++n)                \
            _Pragma("unroll") for (int k = 0; k < 2; ++k)                                                          \
                acc[ai][bj][m][n] = __builtin_amdgcn_mfma_f32_16x16x32_bf16(Bt_[n][k], At_[m][k], acc[ai][bj][m][n], 0, 0, 0); \
        __builtin_amdgcn_s_setprio(0);                                                                             \
    } while (0)
#define WAIT_V(n) asm volatile("s_waitcnt vmcnt(" #n ")" ::: "memory")
#define WAIT_L(n) asm volatile("s_waitcnt lgkmcnt(" #n ")" ::: "memory")
#define BAR __builtin_amdgcn_s_barrier()
#define SCHED __builtin_amdgcn_sched_barrier(0)

    f32x4 acc[2][2][4][2];
#pragma unroll
    for (int a = 0; a < 2; ++a)
#pragma unroll
        for (int b = 0; b < 2; ++b)
#pragma unroll
            for (int m = 0; m < 4; ++m)
#pragma unroll
                for (int n = 0; n < 2; ++n) acc[a][b][m][n] = (f32x4){0.f, 0.f, 0.f, 0.f};
    bf16x8 At[4][2], B0[2][2], B1[2][2];
    const char* cA = Abase + (size_t)pm * tstepA;
    const char* cB = Bbase + (size_t)pn * tstepB;
    STAGE(SB(0, 0), cB + BKOFF(0), voffB); STAGE(SA(0, 0), cA + AKOFF(0), voffA);
    STAGE(SB(0, 1), cB + hstepB + BKOFF(0), voffB); STAGE(SA(0, 1), cA + hstepA + AKOFF(0), voffA);
    if (wr == 1) BAR;
    WAIT_V(4); BAR;
    STAGE(SB(1, 0), cB + BKOFF(1), voffB); STAGE(SA(1, 0), cA + AKOFF(1), voffA); STAGE(SB(1, 1), cB + hstepB + BKOFF(1), voffB);
    WAIT_V(6); BAR;
    for (int ui = 0;; ++ui) {
        int npm, npn;
        const bool has_next = gemm_unit<GID>(ui + 1, npm, npn);
        const char* nA = has_next ? Abase + (size_t)npm * tstepA : cA;
        const char* nB = has_next ? Bbase + (size_t)npn * tstepB : cB;
        for (int t = 0; t < nt; t += 2) {
            const bool last = (t == nt - 2);
            const char* a1 = cA + AKOFF(t + 1);
            const char* a2 = last ? nA + AKOFF(0) : cA + AKOFF(t + 2);
            const char* b2 = last ? nB + BKOFF(0) : cB + BKOFF(t + 2);
            const char* a3 = last ? nA + AKOFF(1) : cA + AKOFF(t + 3);
            const char* b3 = last ? nB + BKOFF(1) : cB + BKOFF(t + 3);
            LDB_(B0, 0, 0); SCHED; LDA_(At, 0, 0); STAGE(SA(1, 1), a1 + hstepA, voffA);
            WAIT_L(8); BAR; WAIT_L(0); MMA(0, 0, At, B0); BAR; SCHED;
            LDB_(B1, 0, 1); STAGE(SB(0, 0), b2, voffB);
            BAR; WAIT_L(0); MMA(0, 1, At, B1); BAR;
            LDA_(At, 0, 1); STAGE(SA(0, 0), a2, voffA);
            BAR; WAIT_L(0); MMA(1, 0, At, B0); BAR; SCHED;
            STAGE(SB(0, 1), b2 + hstepB, voffB);
            WAIT_V(6); BAR; MMA(1, 1, At, B1); BAR;
            LDB_(B0, 1, 0); SCHED; LDA_(At, 1, 0); STAGE(SA(0, 1), a2 + hstepA, voffA);
            WAIT_L(8); BAR; WAIT_L(0); MMA(0, 0, At, B0); BAR; SCHED;
            LDB_(B1, 1, 1); STAGE(SB(1, 0), b3, voffB);
            BAR; WAIT_L(0); MMA(0, 1, At, B1); BAR;
            LDA_(At, 1, 1); STAGE(SA(1, 0), a3, voffA);
            BAR; WAIT_L(0); MMA(1, 0, At, B0); BAR; SCHED;
            STAGE(SB(1, 1), b3 + hstepB, voffB);
            WAIT_V(6); BAR; MMA(1, 1, At, B1); BAR;
        }
        const int brow = pm * 256, bcol = pn * 256;
        if (GID == 1) {
            if (bcol < 6656) {
                bf16_t* dst0 = (bf16_t*)(p->ws + OFF_PROJ) + (size_t)(brow + wr * 64 + fr) * LDP + bcol + wc * 32 + fq * 8;
#pragma unroll
                for (int ai = 0; ai < 2; ++ai)
#pragma unroll
                    for (int m = 0; m < 4; ++m)
#pragma unroll
                        for (int bj = 0; bj < 2; ++bj) {
                            const u32x2 lo = pack4(acc[ai][bj][m][0]), hi = pack4(acc[ai][bj][m][1]);
                            *(u32x4*)(dst0 + (size_t)(ai * HALF + m * 16) * LDP + bj * HALF) = (u32x4){lo[0], lo[1], hi[0], hi[1]};
                        }
                const int hcb = (bcol >= 3584) ? (bcol - 3584 + 1536) : ((bcol >= 1024 && bcol < 2560) ? (bcol - 1024) : -1);
                if (hcb >= 0 && fr >= 13) {
#pragma unroll
                    for (int ai = 0; ai < 2; ++ai) {
                        const int row = brow + ai * HALF + wr * 64 + 48 + fr;
                        bf16_t* hd = (bf16_t*)(p->ws + OFF_HALO) + ((size_t)(row >> 6) * 3 + (fr - 13)) * 4608 + hcb + wc * 32 + fq * 8;
#pragma unroll
                        for (int bj = 0; bj < 2; ++bj) {
                            const u32x2 lo = pack4(acc[ai][bj][3][0]), hi = pack4(acc[ai][bj][3][1]);
                            *(u32x4*)(hd + bj * HALF) = (u32x4){lo[0], lo[1], hi[0], hi[1]};
                        }
                    }
                }
            } else if (wc == 0) {
                float* sd = (float*)(p->ws + OFF_SMALL) + (size_t)(brow + wr * 64 + fr) * 32 + fq * 8;
#pragma unroll
                for (int ai = 0; ai < 2; ++ai)
#pragma unroll
                    for (int m = 0; m < 4; ++m)
#pragma unroll
                        for (int n = 0; n < 2; ++n) *(f32x4*)(sd + (size_t)(ai * HALF + m * 16) * 32 + n * 4) = acc[ai][0][m][n];
            }
        }
        if (!has_next) break;
#pragma unroll
        for (int a = 0; a < 2; ++a)
#pragma unroll
            for (int b = 0; b < 2; ++b)
#pragma unroll
                for (int m = 0; m < 4; ++m)
#pragma unroll
                    for (int n = 0; n < 2; ++n) acc[a][b][m][n] = (f32x4){0.f, 0.f, 0.f, 0.f};
        pm = npm; pn = npn; cA = nA; cB = nB;
    }
    WAIT_V(0);
    if (wr == 0) BAR;
    BAR;
    if (GID == 2) {
        const int brow = pm * 256, bcol = pn * 256;
        LAS float* red = (LAS float*)dsm;
        float* rowss = (float*)(p->ws + OFF_ROWSS);
#pragma unroll
        for (int ai = 0; ai < 2; ++ai)
#pragma unroll
            for (int m = 0; m < 4; ++m) {
                const int rl = ai * HALF + wr * 64 + m * 16 + fr;
                float ss = 0.f;
#pragma unroll
                for (int bj = 0; bj < 2; ++bj)
#pragma unroll
                    for (int n = 0; n < 2; ++n) {
                        const int col = bcol + bj * HALF + wc * 32 + fq * 8 + n * 4;
                        const f32x4 xv = *(const f32x4*)(p->x + (size_t)(brow + rl) * DM + col);
                        f32x4 hv = xv + acc[ai][bj][m][n];
                        acc[ai][bj][m][n] = hv;
                        ss += hv[0] * hv[0] + hv[1] * hv[1] + hv[2] * hv[2] + hv[3] * hv[3];
                    }
                ss += __shfl_xor(ss, 16, 64);
                ss += __shfl_xor(ss, 32, 64);
                if (fq == 0) red[rl * 4 + wc] = ss;
            }
        __syncthreads();
        if (tid < 256) {
            const f32x4 r4 = *(const LAS f32x4*)(red + tid * 4);
            rowss[(size_t)pn * MTOK + brow + tid] = (r4[0] + r4[1]) + (r4[2] + r4[3]);
        }
        if (gridDim.x == 256) {
            asm volatile("s_waitcnt vmcnt(0)" ::: "memory");
            __syncthreads();
            if (threadIdx.x == 0) {
                unsigned* pc = (unsigned*)(p->ws + OFF_BAR) + 64 * (19 + pm);
                __builtin_amdgcn_fence(__ATOMIC_RELEASE, "agent");
                asm volatile("s_waitcnt vmcnt(0)" ::: "memory");
                gb_add(pc);
                while (gb_ld(pc) < 4u) __builtin_amdgcn_s_sleep(1);
                __builtin_amdgcn_fence(__ATOMIC_ACQUIRE, "agent");
                asm volatile("s_waitcnt vmcnt(0)" ::: "memory");
            }
            __syncthreads();
        } else {
            fast_grid_barrier((unsigned*)(p->ws + OFF_BAR), bk);
        }
#pragma unroll
        for (int ai = 0; ai < 2; ++ai)
#pragma unroll
            for (int m = 0; m < 4; ++m) {
                const int row = brow + ai * HALF + wr * 64 + m * 16 + fr;
                const float tot = (rowss[row] + rowss[MTOK + row]) + (rowss[2 * MTOK + row] + rowss[3 * MTOK + row]);
                const float rs = rsqrtf(tot * (1.f / DM) + 1e-6f);
#pragma unroll
                for (int bj = 0; bj < 2; ++bj)
#pragma unroll
                    for (int n = 0; n < 2; ++n) {
                        const int col = bcol + bj * HALF + wc * 32 + fq * 8 + n * 4;
                        const f32x4 wv = *(const f32x4*)(p->final_norm_w + col);
                        *(f32x4*)(p->out + (size_t)row * DM + col) = acc[ai][bj][m][n] * rs * wv;
                    }
            }
    }
#undef SA
#undef SB
#undef STAGE
#undef LDA_
#undef LDB_
#undef MMA
#undef AKOFF
#undef BKOFF
}

__device__ __forceinline__ void conv8x8(const bf16_t* __restrict__ projcol, const bf16_t* __restrict__ halocol, bool first, int l0,
                                        const float* __restrict__ cw, int cwld, const float* __restrict__ bias, float (&val)[8][8]) {
    float w[4][8];
#pragma unroll
    for (int k = 0; k < 4; k++) {
        const float4 a = *(const float4*)(cw + (size_t)k * cwld), b = *(const float4*)(cw + (size_t)k * cwld + 4);
        w[k][0] = a.x; w[k][1] = a.y; w[k][2] = a.z; w[k][3] = a.w; w[k][4] = b.x; w[k][5] = b.y; w[k][6] = b.z; w[k][7] = b.w;
    }
    float bb[8];
#pragma unroll
    for (int i = 0; i < 8; i++) bb[i] = 0.f;
    if (bias) {
        const float4 a = *(const float4*)(bias), b = *(const float4*)(bias + 4);
        bb[0] = a.x; bb[1] = a.y; bb[2] = a.z; bb[3] = a.w; bb[4] = b.x; bb[5] = b.y; bb[6] = b.z; bb[7] = b.w;
    }
    float x0[8], x1[8], x2[8];
#pragma unroll
    for (int i = 0; i < 8; i++) { x0[i] = 0.f; x1[i] = 0.f; x2[i] = 0.f; }
#pragma unroll
    for (int r = -3; r < 8; r++) {
        const int l = l0 + r;
        bf16x8 raw = {0, 0, 0, 0, 0, 0, 0, 0};
        if (l >= 0) raw = *(const bf16x8*)(projcol + (size_t)l * LDP);
        else if (!first) raw = *(const bf16x8*)(halocol + (size_t)(l + 3) * 4608);
        float cur[8];
        unpack8(raw, cur);
        if (r >= 0) {
#pragma unroll
            for (int i = 0; i < 8; i++) {
                const float a = bb[i] + w[0][i] * x0[i] + w[1][i] * x1[i] + w[2][i] * x2[i] + w[3][i] * cur[i];
                val[r][i] = silu_f(a);
            }
        }
#pragma unroll
        for (int i = 0; i < 8; i++) { x0[i] = x1[i]; x1[i] = x2[i]; x2[i] = cur[i]; }
    }
}

template <int VAR>
__device__ __forceinline__ void gdn_item(PP p, const int ch, const int h) {
    LAS char* lb = (LAS char*)dsm;
    asm volatile("" : "+v"(lb));
    LAS bf16_t* QN = (LAS bf16_t*)lb;
    LAS bf16_t* KN = (LAS bf16_t*)(lb + 17408);
    LAS float* VF = (LAS float*)(lb + 34816);
    LAS float* AM = (LAS float*)(lb + 67584);
    LAS float* GC = (LAS float*)(lb + 84992);
    LAS float* BETA = GC + 64;
    LAS float* EG = GC + 128;
    LAS float* TI = (LAS float*)(lb + 85760);
    int tid = threadIdx.x;
    asm volatile("" : "+v"(tid));
    const int lane = tid & 63, wid = tid >> 6, fr = lane & 15, fq = lane >> 4;
    bf16_t* PROJ = (bf16_t*)(p->ws + OFF_PROJ);
    float* SMALL = (float*)(p->ws + OFF_SMALL);
    const bf16_t* HALO = (const bf16_t*)(p->ws + OFF_HALO);
    bf16_t* QD = (bf16_t*)p->out;
    bf16_t* ATTN = (bf16_t*)((char*)p->out + OUT_ATTN_OFF);
    const size_t row0 = (size_t)ch * 64;
    const int item = ch * 8 + h;
    const bool first = (ch & 127) == 0;
    {
        const int g16 = tid >> 4, c8 = tid & 15, blk = g16 >> 3, tr = g16 & 7, l0 = tr * 8;
        if (blk < 3) {
            const int cc = blk * 1024 + h * 128 + c8 * 8;
            float val[8][8];
            conv8x8(PROJ + row0 * LDP + QKV0 + cc, HALO + (size_t)(ch - 1) * 3 * 4608 + 1536 + cc, first, l0,
                    p->gdn_conv_w + cc, 3072, nullptr, val);
            if (blk < 2) {
                LAS bf16_t* ldst = blk == 0 ? QN : KN;
                const float extra = blk == 0 ? 0.08838834764831845f : 1.f;
#pragma unroll
                for (int t = 0; t < 8; t++) {
                    float ss = 0.f;
#pragma unroll
                    for (int i = 0; i < 8; i++) ss += val[t][i] * val[t][i];
                    ss += __shfl_xor(ss, 1, 64); ss += __shfl_xor(ss, 2, 64); ss += __shfl_xor(ss, 4, 64); ss += __shfl_xor(ss, 8, 64);
                    const float sc = rsqrtf(ss + 1e-6f) * extra;
                    float f[8];
#pragma unroll
                    for (int i = 0; i < 8; i++) f[i] = val[t][i] * sc;
                    *(LAS u32x4*)(ldst + (l0 + t) * 136 + c8 * 8) = pack8(f);
                }
            } else {
#pragma unroll
                for (int t = 0; t < 8; t++) {
                    *(LAS f32x4*)(VF + (l0 + t) * 128 + c8 * 8) = (f32x4){val[t][0], val[t][1], val[t][2], val[t][3]};
                    *(LAS f32x4*)(VF + (l0 + t) * 128 + c8 * 8 + 4) = (f32x4){val[t][4], val[t][5], val[t][6], val[t][7]};
                }
            }
        } else if (wid == 7) {
            float* sa = SMALL + (row0 + lane) * 32 + 16 + h;
            const float a_raw = sa[0], b_raw = sa[8];
            const float beta = 1.f / (1.f + expf(-b_raw));
            const float g = -expf(p->gdn_a_log[h]) * softplus_f(a_raw + p->gdn_dt_bias[h]);
            const float gc = wave_incl_scan(g, lane);
            const float eg = expf(gc);
            GC[lane] = gc; BETA[lane] = beta; EG[lane] = eg;
            sa[0] = eg;
        }
    }
    __syncthreads();
    {
        const int i = wid & 3, jj = wid >> 2;
#pragma unroll
        for (int jt = 0; jt < 2; jt++) {
            const int j = jj * 2 + jt;
            f32x4 aK = {0.f, 0.f, 0.f, 0.f}, aQ = {0.f, 0.f, 0.f, 0.f};
            if (j <= i) {
#pragma unroll
                for (int ks = 0; ks < 4; ks++) {
                    const bf16x8 kj = *(const LAS bf16x8*)(KN + (16 * j + fr) * 136 + 32 * ks + 8 * fq);
                    const bf16x8 ki = *(const LAS bf16x8*)(KN + (16 * i + fr) * 136 + 32 * ks + 8 * fq);
                    const bf16x8 qi = *(const LAS bf16x8*)(QN + (16 * i + fr) * 136 + 32 * ks + 8 * fq);
                    aK = mfma16(kj, ki, aK);
                    aQ = mfma16(kj, qi, aQ);
                }
            }
            const int l = 16 * i + fr;
            const float gl_ = GC[l], bl = BETA[l];
            f32x4 am, at;
#pragma unroll
            for (int r = 0; r < 4; r++) {
                const int s = 16 * j + 4 * fq + r;
                const float dec = (l >= s) ? __expf(gl_ - GC[s]) : 0.f;
                am[r] = (l > s) ? bl * aK[r] * dec : 0.f;
                at[r] = (l >= s) ? aQ[r] * dec : 0.f;
            }
            *(LAS f32x4*)(AM + l * 68 + 16 * j + 4 * fq) = am;
            *(u32x2*)(ATTN + ((size_t)item * 64 + l) * 64 + 16 * j + 4 * fq) = pack4(at);
        }
    }
    __syncthreads();
    if (VAR == 13) { __syncthreads(); return; }
    if (wid == 0) {
        const int blk = lane >> 4, j = lane & 15;
        float x[16];
#pragma unroll
        for (int r = 0; r < 16; r++) {
            float v = (r == j) ? 1.f : 0.f;
#pragma unroll
            for (int m4 = 0; m4 * 4 < r; m4++) {
                const f32x4 a = *(const LAS f32x4*)(AM + (16 * blk + r) * 68 + 16 * blk + m4 * 4);
#pragma unroll
                for (int q = 0; q < 4; q++)
                    if (m4 * 4 + q < r) v -= a[q] * x[m4 * 4 + q];
            }
            x[r] = v;
            TI[blk * 256 + r * 16 + j] = v;
        }
    } else if (wid >= 4) {
        const int t2 = tid - 256;
        const float gL = GC[63];
#pragma unroll
        for (int it = 0; it < 4; it++) {
            const int o = t2 + 256 * it, l = o >> 4, d8 = (o & 15) * 8;
            const bf16x8 q = *(const LAS bf16x8*)(QN + l * 136 + d8);
            float f[8];
            unpack8(q, f);
            const float e = EG[l];
#pragma unroll
            for (int i = 0; i < 8; i++) f[i] *= e;
            *(u32x4*)(QD + ((size_t)item * 64 + l) * 128 + d8) = pack8(f);
        }
#pragma unroll
        for (int it = 0; it < 4; it++) {
            const int o = t2 + 256 * it, d = o & 127, l8 = (o >> 7) * 8;
            float f[8];
#pragma unroll
            for (int t = 0; t < 8; t++) f[t] = bf2f(KN[(l8 + t) * 136 + d]) * __expf(gL - GC[l8 + t]);
            *(u32x4*)(PROJ + (row0 + (d >> 1)) * LDP + QKV0 + 1024 + h * 128 + (d & 1) * 64 + l8) = pack8(f);
        }
    }
    __syncthreads();
    {
        const bool isv = wid < 4;
#pragma unroll
        for (int cc = 0; cc < 2; cc++) {
            const int n = 16 * (2 * wid + cc) + fr;
            f32x4 X[4];
#pragma unroll
            for (int i = 0; i < 4; i++) {
                f32x4 acc;
#pragma unroll
                for (int r = 0; r < 4; r++) {
                    const int l = 16 * i + 4 * fq + r;
                    acc[r] = isv ? VF[l * 128 + n] * BETA[l] : bf2f(KN[l * 136 + (n & 127)]) * (BETA[l] * EG[l]);
                }
#pragma unroll
                for (int j = 0; j < i; j++) {
                    const f32x4 av = *(const LAS f32x4*)(AM + (16 * i + fr) * 68 + 16 * j + 4 * fq);
#pragma unroll
                    for (int q = 0; q < 4; q++) acc = __builtin_amdgcn_mfma_f32_16x16x4f32(-av[q], X[j][q], acc, 0, 0, 0);
                }
                const f32x4 tv = *(const LAS f32x4*)(TI + i * 256 + fr * 16 + 4 * fq);
                f32x4 xi = {0.f, 0.f, 0.f, 0.f};
#pragma unroll
                for (int q = 0; q < 4; q++) xi = __builtin_amdgcn_mfma_f32_16x16x4f32(tv[q], acc[q], xi, 0, 0, 0);
                X[i] = xi;
            }
            if (isv) {
                bf16_t* dst = PROJ + (row0 + (n >> 1)) * LDP + QKV0 + 2048 + h * 128 + (n & 1) * 64 + 4 * fq;
#pragma unroll
                for (int i = 0; i < 4; i++) *(u32x2*)(dst + 16 * i) = pack4(X[i]);
            } else {
                bf16_t* dst = PROJ + (row0 + 4 * fq) * LDP + QKV0 + h * 128 + (n & 127);
#pragma unroll
                for (int i = 0; i < 4; i++)
#pragma unroll
                    for (int r = 0; r < 4; r++) dst[(size_t)(16 * i + r) * LDP] = f2bf(X[i][r]);
            }
        }
    }
    __syncthreads();
}

__device__ __forceinline__ int xdt_off(int row, int l) { return row * 72 + ((((l >> 3) ^ ((row >> 3) & 7)) << 3) | (l & 7)); }

template <int VAR>
__device__ __forceinline__ void ssd_item(PP p, const int ch, const int g) {
    LAS char* lb = (LAS char*)dsm;
    asm volatile("" : "+v"(lb));
    LAS float* DT = (LAS float*)lb;
    LAS float* LC = (LAS float*)(lb + 2048);
    LAS bf16_t* XDT = (LAS bf16_t*)(lb + 4096);
    LAS bf16_t* BN = (LAS bf16_t*)(lb + 77824);
    LAS bf16_t* CN = (LAS bf16_t*)(lb + 95232);
    LAS float* CB = (LAS float*)(lb + 112640);
    LAS float* ES = (LAS float*)(lb + 130048);
    int tid = threadIdx.x;
    asm volatile("" : "+v"(tid));
    const int lane = tid & 63, wid = tid >> 6, fr = lane & 15, fq = lane >> 4;
    bf16_t* PROJ = (bf16_t*)(p->ws + OFF_PROJ);
    float* SMALL = (float*)(p->ws + OFF_SMALL);
    const bf16_t* HALO = (const bf16_t*)(p->ws + OFF_HALO);
    bf16_t* YPART = (bf16_t*)(p->ws + OFF_YPART);
    const size_t row0 = (size_t)ch * 64;
    const bool first = (ch & 127) == 0;
    {
        const int hh = 8 * g + wid;
        float* sp = SMALL + (row0 + lane) * 32 + hh;
        const float dt = softplus_f(sp[0] + p->ssd_dt_bias[hh]);
        const float la = -expf(p->ssd_a_log[hh]) * dt;
        const float lc = wave_incl_scan(la, lane);
        DT[wid * 64 + lane] = dt;
        LC[wid * 64 + lane] = lc;
        ES[wid * 64 + lane] = __expf(__shfl(lc, 63, 64) - lc);
        sp[0] = expf(lc);
    }
    __syncthreads();
    for (int task = tid; task < 768; task += 512) {
        const int co = task % 96, tr = task / 96, l0 = tr * 8;
        const int xc = (co < 64) ? g * 512 + co * 8 : (co < 80 ? 1024 + g * 128 + (co - 64) * 8 : 1280 + g * 128 + (co - 80) * 8);
        float val[8][8];
        conv8x8(PROJ + row0 * LDP + XBC0 + xc, HALO + (size_t)(ch - 1) * 3 * 4608 + xc, first, l0,
                p->ssd_conv_w + xc, 1536, p->ssd_conv_b + xc, val);
        if (co < 64) {
            const int hl = co >> 3, p0 = (co & 7) * 8;
            float dtv[8];
#pragma unroll
            for (int t = 0; t < 8; t++) dtv[t] = DT[hl * 64 + l0 + t];
#pragma unroll
            for (int i = 0; i < 8; i++) {
                float f[8];
#pragma unroll
                for (int t = 0; t < 8; t++) f[t] = val[t][i] * dtv[t];
                *(LAS u32x4*)(XDT + xdt_off(hl * 64 + p0 + i, l0)) = pack8(f);
            }
        } else {
            LAS bf16_t* ldst = (co < 80) ? BN : CN;
            const int n0 = ((co - 64) & 15) * 8;
#pragma unroll
            for (int t = 0; t < 8; t++) *(LAS u32x4*)(ldst + (l0 + t) * 136 + n0) = pack8(val[t]);
        }
    }
    __syncthreads();
    if (VAR == 17) { __syncthreads(); return; }
#pragma unroll
    for (int it = 0; it < 8; it++) {
        const int idx = tid + 512 * it, hl = idx >> 9, pp = (idx >> 3) & 63, l0 = (idx & 7) * 8;
        const bf16x8 a = *(const LAS bf16x8*)(XDT + xdt_off(hl * 64 + pp, l0));
        float f[8];
        unpack8(a, f);
        const f32x4 e0 = *(const LAS f32x4*)(ES + hl * 64 + l0), e1 = *(const LAS f32x4*)(ES + hl * 64 + l0 + 4);
#pragma unroll
        for (int t = 0; t < 4; t++) { f[t] *= e0[t]; f[4 + t] *= e1[t]; }
        *(u32x4*)(PROJ + (row0 + pp) * LDP + XBC0 + (8 * g + hl) * 64 + l0) = pack8(f);
    }
#pragma unroll
    for (int it = 0; it < 2; it++) {
        const int idx = tid + 512 * it, n = idx & 127, l0 = (idx >> 7) * 8;
        u32x4 o;
#pragma unroll
        for (int t = 0; t < 4; t++)
            o[t] = (unsigned)BN[(l0 + 2 * t) * 136 + n] | ((unsigned)BN[(l0 + 2 * t + 1) * 136 + n] << 16);
        *(u32x4*)(PROJ + (row0 + (n >> 1)) * LDP + XBC0 + 1024 + g * 128 + (n & 1) * 64 + l0) = o;
    }
#pragma unroll
    for (int it = 0; it < 2; it++) {
        const int idx = tid + 512 * it, l = idx >> 4, n8 = (idx & 15) * 8;
        *(u32x4*)(PROJ + (row0 + l) * LDP + XBC0 + 1280 + g * 128 + n8) = *(const LAS u32x4*)(CN + l * 136 + n8);
    }
    {
        const int i = wid & 3, jj = wid >> 2;
#pragma unroll
        for (int jt = 0; jt < 2; jt++) {
            const int j = jj * 2 + jt;
            f32x4 a = {0.f, 0.f, 0.f, 0.f};
#pragma unroll
            for (int ks = 0; ks < 4; ks++) {
                const bf16x8 bs = *(const LAS bf16x8*)(BN + (16 * j + fr) * 136 + 32 * ks + 8 * fq);
                const bf16x8 cl = *(const LAS bf16x8*)(CN + (16 * i + fr) * 136 + 32 * ks + 8 * fq);
                a = mfma16(bs, cl, a);
            }
            *(LAS f32x4*)(CB + (16 * i + fr) * 68 + 16 * j + 4 * fq) = a;
        }
    }
    __syncthreads();
    if (VAR == 18) { __syncthreads(); return; }
    {
        const int hh = 8 * g + wid;
        f32x4 acc[4][4];
#pragma unroll
        for (int a = 0; a < 4; a++)
#pragma unroll
            for (int b = 0; b < 4; b++) acc[a][b] = (f32x4){0.f, 0.f, 0.f, 0.f};
#pragma unroll
        for (int i = 0; i < 4; i++) {
            const int l = 16 * i + fr;
            const float lcl = LC[wid * 64 + l];
#pragma unroll
            for (int ks = 0; ks < 2; ks++) {
                if (32 * ks > 16 * i + 15) continue;
                const int s0 = 32 * ks + 8 * fq;
                const f32x4 cb0 = *(const LAS f32x4*)(CB + l * 68 + s0), cb1 = *(const LAS f32x4*)(CB + l * 68 + s0 + 4);
                const f32x4 ls0 = *(const LAS f32x4*)(LC + wid * 64 + s0), ls1 = *(const LAS f32x4*)(LC + wid * 64 + s0 + 4);
                float mv[8];
#pragma unroll
                for (int t = 0; t < 4; t++) {
                    mv[t] = (s0 + t <= l) ? cb0[t] * __expf(lcl - ls0[t]) : 0.f;
                    mv[4 + t] = (s0 + 4 + t <= l) ? cb1[t] * __expf(lcl - ls1[t]) : 0.f;
                }
                const bf16x8 mf = __builtin_bit_cast(bf16x8, pack8(mv));
#pragma unroll
                for (int pt = 0; pt < 4; pt++) {
                    const bf16x8 a = *(const LAS bf16x8*)(XDT + xdt_off(wid * 64 + 16 * pt + fr, s0));
                    acc[pt][i] = mfma16(a, mf, acc[pt][i]);
                }
            }
        }
        const float dcoef0 = p->ssd_d[hh];
#pragma unroll
        for (int i = 0; i < 4; i++) {
            const int l = 16 * i + fr;
            const float dcoef = dcoef0 / DT[wid * 64 + l];
#pragma unroll
            for (int pt = 0; pt < 4; pt++) {
                f32x4 v = acc[pt][i];
#pragma unroll
                for (int r = 0; r < 4; r++) v[r] += dcoef * bf2f(XDT[xdt_off(wid * 64 + 16 * pt + 4 * fq + r, l)]);
                *(u32x2*)(YPART + (row0 + l) * 1024 + hh * 64 + 16 * pt + 4 * fq) = pack4(v);
            }
        }
    }
    __syncthreads();
}

template <int VAR>
__device__ __forceinline__ void phase_b(PP p) {
    for (int it = blockIdx.x; it < 2560; it += gridDim.x) {
        if (it < 2048) { if (VAR != 14 && VAR != 17 && VAR != 18) gdn_item<VAR>(p, it >> 3, it & 7); }
        else if (VAR == 0 || VAR == 14) ssd_item<0>(p, (it - 2048) >> 1, (it - 2048) & 1);
        else if (VAR == 17 || VAR == 18) ssd_item<VAR>(p, (it - 2048) >> 1, (it - 2048) & 1);
    }
}

struct GdnOps { bf16x8 wA[4], qA[4], aA[2], kA[2][2]; bf16x4 u; float gl; };

template <int DRY>
__device__ __forceinline__ void gdn_scan(PP p, const int bh, const int es) {
    LAS char* lb = (LAS char*)dsm;
    asm volatile("" : "+v"(lb));
    LAS bf16_t* SBuf = (LAS bf16_t*)lb;
    LAS bf16_t* VN = (LAS bf16_t*)(lb + 8704);
    const int tid = tid_opaque(), lane = tid & 63, wid = tid >> 6, fr = lane & 15, fq = lane >> 4;
    bf16_t* PROJ = (bf16_t*)(p->ws + OFF_PROJ);
    const float* SMALL = (const float*)(p->ws + OFF_SMALL);
    const bf16_t* QD = (const bf16_t*)p->out;
    const bf16_t* ATTN = (const bf16_t*)((const char*)p->out + OUT_ATTN_OFF);
    const int b = bh >> 3, h = bh & 7;
    const int i = wid & 3, jc = wid >> 2;
    const int e_loc = 16 * jc + fr, e = es * 32 + e_loc;
    const int dt0 = 2 * i;
    for (int idx = tid; idx < 32 * 136 / 2; idx += NTHR) ((LAS unsigned*)SBuf)[idx] = 0u;
    f32x4 S0 = {0.f, 0.f, 0.f, 0.f}, S1 = {0.f, 0.f, 0.f, 0.f};

    auto load = [&](int c, GdnOps& o) {
        const int ch = b * 128 + c;
        const size_t row0 = (size_t)ch * 64;
        const int item = ch * 8 + h;
        const bf16_t* wrow = PROJ + (row0 + 16 * i + fr) * LDP + QKV0 + h * 128 + 8 * fq;
        const bf16_t* qrow = QD + ((size_t)item * 64 + 16 * i + fr) * 128 + 8 * fq;
        const bf16_t* arow = ATTN + ((size_t)item * 64 + 16 * i + fr) * 64 + 8 * fq;
#pragma unroll
        for (int ks = 0; ks < 4; ks++) { o.wA[ks] = *(const bf16x8*)(wrow + 32 * ks); o.qA[ks] = *(const bf16x8*)(qrow + 32 * ks); }
#pragma unroll
        for (int ks = 0; ks < 2; ks++) o.aA[ks] = *(const bf16x8*)(arow + 32 * ks);
#pragma unroll
        for (int t = 0; t < 2; t++) {
            const int d = 16 * (dt0 + t) + fr;
            const bf16_t* krow = PROJ + (row0 + (d >> 1)) * LDP + QKV0 + 1024 + h * 128 + (d & 1) * 64 + 8 * fq;
#pragma unroll
            for (int ks = 0; ks < 2; ks++) o.kA[t][ks] = *(const bf16x8*)(krow + 32 * ks);
        }
        o.u = *(const bf16x4*)(PROJ + (row0 + (e >> 1)) * LDP + QKV0 + 2048 + h * 128 + (e & 1) * 64 + 16 * i + 4 * fq);
        o.gl = SMALL[(row0 + 63) * 32 + 16 + h];
    };
    float sink = 0.f;
    GdnOps cur, nxt;
    load(0, cur);
    nxt = cur;
    lds_barrier();
    for (int c = 0; c < 128; c++) {
        if (c + 1 < 128) load(c + 1, nxt);
        f32x4 aP = {0.f, 0.f, 0.f, 0.f}, aO = {0.f, 0.f, 0.f, 0.f};
#pragma unroll
        for (int ks = 0; ks < 4; ks++) {
            const bf16x8 bS = *(const LAS bf16x8*)(SBuf + e_loc * 136 + 32 * ks + 8 * fq);
            aP = mfma16(cur.wA[ks], bS, aP);
            aO = mfma16(cur.qA[ks], bS, aO);
        }
        {
            float uf[4];
            unpack4(cur.u, uf);
            f32x4 vn;
#pragma unroll
            for (int r = 0; r < 4; r++) vn[r] = uf[r] - aP[r];
            *(LAS u32x2*)(VN + e_loc * 72 + 16 * i + 4 * fq) = pack4(vn);
        }
        lds_barrier();
        bf16x8 bV[2];
#pragma unroll
        for (int ks = 0; ks < 2; ks++) bV[ks] = *(const LAS bf16x8*)(VN + e_loc * 72 + 32 * ks + 8 * fq);
#pragma unroll
        for (int ks = 0; ks < 2; ks++) aO = mfma16(cur.aA[ks], bV[ks], aO);
        {
            const size_t row0 = (size_t)(b * 128 + c) * 64;
            bf16_t* od = PROJ + (row0 + (e >> 1)) * LDP + QKV0 + 2048 + h * 128 + (e & 1) * 64 + 16 * i + 4 * fq;
            if (DRY) od = (bf16_t*)((char*)p->out + 52428800 + (((size_t)((char*)od - (char*)PROJ)) & 0x7ffff8));
            if (DRY == 2) sink += aO[0] + aO[1] + aO[2] + aO[3]; else *(u32x2*)od = pack4(aO);
        }
        S0 *= cur.gl; S1 *= cur.gl;
#pragma unroll
        for (int ks = 0; ks < 2; ks++) { S0 = mfma16(cur.kA[0][ks], bV[ks], S0); S1 = mfma16(cur.kA[1][ks], bV[ks], S1); }
        *(LAS u32x2*)(SBuf + e_loc * 136 + 16 * dt0 + 4 * fq) = pack4(S0);
        *(LAS u32x2*)(SBuf + e_loc * 136 + 16 * (dt0 + 1) + 4 * fq) = pack4(S1);
        lds_barrier();
        cur = nxt;
    }
    if (DRY == 2) *(float*)((char*)p->out + 52428800 + (size_t)(blockIdx.x * NTHR + tid) * 4) = sink;
}

struct SsdOps { bf16x8 cB[4], bA[2], xB[4][2]; bf16x4 yp[2]; float elc, dec; };

template <int DRY>
__device__ __forceinline__ void ssd_scan(PP p, const int bh) {
    LAS char* lb = (LAS char*)dsm;
    asm volatile("" : "+v"(lb));
    LAS bf16_t* HT = (LAS bf16_t*)lb;
    const int tid = tid_opaque(), lane = tid & 63, wid = tid >> 6, fr = lane & 15, fq = lane >> 4;
    bf16_t* PROJ = (bf16_t*)(p->ws + OFF_PROJ);
    const float* SMALL = (const float*)(p->ws + OFF_SMALL);
    bf16_t* YPART = (bf16_t*)(p->ws + OFF_YPART);
    const int b = bh >> 4, hh = bh & 15, g = hh >> 3;
    const int i = wid & 3, ptb = 2 * (wid >> 2);
    for (int idx = tid; idx < 64 * 136 / 2; idx += NTHR) ((LAS unsigned*)HT)[idx] = 0u;
    f32x4 hs[4];
#pragma unroll
    for (int t = 0; t < 4; t++) hs[t] = (f32x4){0.f, 0.f, 0.f, 0.f};
    auto load = [&](int c, SsdOps& o) {
        const size_t row0 = (size_t)(b * 128 + c) * 64;
        const bf16_t* crow = PROJ + (row0 + 16 * i + fr) * LDP + XBC0 + 1280 + g * 128 + 8 * fq;
#pragma unroll
        for (int ks = 0; ks < 4; ks++) o.cB[ks] = *(const bf16x8*)(crow + 32 * ks);
        const int n = 16 * wid + fr;
        const bf16_t* brow_ = PROJ + (row0 + (n >> 1)) * LDP + XBC0 + 1024 + g * 128 + (n & 1) * 64 + 8 * fq;
#pragma unroll
        for (int ks = 0; ks < 2; ks++) o.bA[ks] = *(const bf16x8*)(brow_ + 32 * ks);
#pragma unroll
        for (int pt = 0; pt < 4; pt++) {
            const bf16_t* xrow = PROJ + (row0 + 16 * pt + fr) * LDP + XBC0 + hh * 64 + 8 * fq;
#pragma unroll
            for (int ks = 0; ks < 2; ks++) o.xB[pt][ks] = *(const bf16x8*)(xrow + 32 * ks);
        }
#pragma unroll
        for (int t = 0; t < 2; t++) o.yp[t] = *(const bf16x4*)(YPART + (row0 + 16 * i + fr) * 1024 + hh * 64 + 16 * (ptb + t) + 4 * fq);
        o.elc = SMALL[(row0 + 16 * i + fr) * 32 + hh];
        o.dec = SMALL[(row0 + 63) * 32 + hh];
    };
    float sink = 0.f;
    SsdOps cur, nxt;
    load(0, cur);
    nxt = cur;
    lds_barrier();
    for (int c = 0; c < 128; c++) {
        if (c + 1 < 128) load(c + 1, nxt);
        const LAS bf16_t* Hc = HT + (c & 1) * 8704;
        LAS bf16_t* Hn = HT + ((c & 1) ^ 1) * 8704;
        const size_t row0 = (size_t)(b * 128 + c) * 64;
#pragma unroll
        for (int t = 0; t < 2; t++) {
            const int pt = ptb + t;
            f32x4 a = {0.f, 0.f, 0.f, 0.f};
#pragma unroll
            for (int ks = 0; ks < 4; ks++) {
                const bf16x8 hf = *(const LAS bf16x8*)(Hc + (16 * pt + fr) * 136 + 32 * ks + 8 * fq);
                a = mfma16(hf, cur.cB[ks], a);
            }
            float yf[4];
            unpack4(cur.yp[t], yf);
            f32x4 y;
#pragma unroll
            for (int r = 0; r < 4; r++) y[r] = yf[r] + cur.elc * a[r];
            bf16_t* yd = YPART + (row0 + 16 * i + fr) * 1024 + hh * 64 + 16 * pt + 4 * fq;
            if (DRY) yd = (bf16_t*)((char*)p->out + 52428800 + (((size_t)((char*)yd - (char*)YPART)) & 0x7ffff8));
            if (DRY == 2) sink += y[0] + y[1] + y[2] + y[3]; else *(u32x2*)yd = pack4(y);
        }
#pragma unroll
        for (int pt = 0; pt < 4; pt++) {
            hs[pt] *= cur.dec;
#pragma unroll
            for (int ks = 0; ks < 2; ks++) hs[pt] = mfma16(cur.bA[ks], cur.xB[pt][ks], hs[pt]);
            *(LAS u32x2*)(Hn + (16 * pt + fr) * 136 + 16 * wid + 4 * fq) = pack4(hs[pt]);
        }
        lds_barrier();
        cur = nxt;
    }
    if (DRY == 2) *(float*)((char*)p->out + 52428800 + (size_t)(blockIdx.x * NTHR + tid) * 4) = sink;
}


constexpr int G2_SLOT0 = 13376, G2_SLOTB = 67072;
constexpr int G2_W = 0, G2_Q = 17408, G2_K = 34816, G2_A = 53248, G2_U = 62464;
struct GdnStage { u32x4 r[8]; float gl; };

template <int DRY, int MODE>
__device__ __forceinline__ void gdn_scan2(PP p, const int bh, const int es, const int c0) {
    LAS char* lb = (LAS char*)dsm;
    asm volatile("" : "+v"(lb));
    LAS bf16_t* SBuf = (LAS bf16_t*)lb;
    LAS bf16_t* VN = (LAS bf16_t*)(lb + 8704);
    LAS float* GL = (LAS float*)(lb + 13312);
    const int tid = tid_opaque(), lane = tid & 63, wid = __builtin_amdgcn_readfirstlane(tid >> 6), fr = lane & 15, fq = lane >> 4;
    bf16_t* PROJ = (bf16_t*)(p->ws + OFF_PROJ);
    const float* SMALL = (const float*)(p->ws + OFF_SMALL);
    const int b = bh >> 3, h = bh & 7;
    if (MODE == 1) {
        for (int idx = tid; idx < 32 * 136; idx += NTHR) { const int e_ = idx / 136, d_ = idx - e_ * 136; SBuf[idx] = (d_ == es * 32 + e_) ? (bf16_t)0x3F80 : (bf16_t)0; }
    } else {
        for (int idx = tid; idx < 32 * 136 / 2; idx += NTHR) ((LAS unsigned*)SBuf)[idx] = 0u;
    }
    const int lr = tid >> 4, c16 = tid & 15;
    const size_t rowb = (size_t)(b * 128) * 64;
    const char* gW = (const char*)PROJ + ((rowb + lr) * LDP + QKV0 + h * 128) * 2 + c16 * 16;
    const char* gU = (const char*)PROJ + ((rowb + es * 16 + (lr & 15)) * LDP + QKV0 + 2048 + h * 128) * 2 + c16 * 16;
    const char* gQ = (const char*)p->out + ((size_t)(b * 128 * 8 + h)) * 16384 + tid * 16;
    const char* gA = (const char*)p->out + OUT_ATTN_OFF + ((size_t)(b * 128 * 8 + h)) * 8192 + tid * 16;
    const float* gG = SMALL + (rowb + 63) * 32 + 16 + h;
    const unsigned dW = (unsigned)(lr * 136 + c16 * 8) * 2;
    const unsigned dK = (unsigned)((2 * lr + (c16 >> 3)) * 72 + (c16 & 7) * 8) * 2;
    const unsigned dA = (unsigned)((tid >> 3) * 72 + (tid & 7) * 8) * 2;
    const unsigned dU = (unsigned)((2 * (lr & 15) + (c16 >> 3)) * 72 + (c16 & 7) * 8) * 2;
    auto issue = [&](int c, GdnStage& st) {
        c = c > c0 + 63 ? c0 + 63 : c;
        if (DRY == 3) c = 0;
        const int cs = (DRY == 4) ? 0 : c, cq = (DRY == 5) ? 0 : c;
        const size_t co = (size_t)cs * 64 * LDP * 2;
#pragma unroll
        for (int j = 0; j < 2; j++) st.r[j] = *(const u32x4*)(gW + co + (size_t)j * 32 * LDP * 2);
#pragma unroll
        for (int j = 0; j < 2; j++) st.r[2 + j] = *(const u32x4*)(gW + 2048 + co + (size_t)j * 32 * LDP * 2);
#pragma unroll
        for (int j = 0; j < 2; j++) st.r[4 + j] = *(const u32x4*)(gQ + (size_t)cq * 8 * 16384 + j * 8192);
        st.r[6] = *(const u32x4*)(gA + (size_t)cq * 8 * 8192);
        if (wid < 4) st.r[7] = *(const u32x4*)(gU + co);
        st.gl = gG[(size_t)c * 64 * 32];
    };
    auto commit = [&](const GdnStage& st, int slot) {
        LAS char* sb = lb + G2_SLOT0 + slot * G2_SLOTB;
#pragma unroll
        for (int j = 0; j < 2; j++) *(LAS u32x4*)(sb + G2_W + dW + j * 32 * 272) = st.r[j];
#pragma unroll
        for (int j = 0; j < 2; j++) *(LAS u32x4*)(sb + G2_K + dK + j * 64 * 144) = st.r[2 + j];
#pragma unroll
        for (int j = 0; j < 2; j++) *(LAS u32x4*)(sb + G2_Q + dW + j * 32 * 272) = st.r[4 + j];
        *(LAS u32x4*)(sb + G2_A + dA) = st.r[6];
        if (wid < 4) *(LAS u32x4*)(sb + G2_U + dU) = st.r[7];
        if (tid == 0) GL[slot] = st.gl;
    };
    const int i = wid & 3, jc = wid >> 2;
    const int e_loc = 16 * jc + fr, e = es * 32 + e_loc;
    const int dt0 = 2 * i;
    f32x4 S0 = {0.f, 0.f, 0.f, 0.f}, S1 = {0.f, 0.f, 0.f, 0.f};
    if (MODE == 1) {
#pragma unroll
        for (int r = 0; r < 4; r++) {
            S0[r] = (16 * dt0 + 4 * fq + r == es * 32 + e_loc) ? 1.f : 0.f;
            S1[r] = (16 * (dt0 + 1) + 4 * fq + r == es * 32 + e_loc) ? 1.f : 0.f;
        }
    }
    float sink = 0.f;
    GdnStage R0, R1, R2, R3;
#pragma unroll
    for (int j = 0; j < 8; j++) { R0.r[j] = (u32x4){0u, 0u, 0u, 0u}; R1.r[j] = R0.r[j]; R2.r[j] = R0.r[j]; R3.r[j] = R0.r[j]; }
    issue(c0, R0);
    commit(R0, 0);
    issue(c0 + 1, R1); issue(c0 + 2, R2); issue(c0 + 3, R3);
    lds_barrier();
    auto step = [&](const int c, GdnStage& R, GdnStage& RI) {
        const int slot = c & 1;
        LAS char* sb = lb + G2_SLOT0 + slot * G2_SLOTB;
        commit(R, slot ^ 1);
        issue(c + 4, RI);
        f32x4 aP = {0.f, 0.f, 0.f, 0.f}, aO = {0.f, 0.f, 0.f, 0.f};
#pragma unroll
        for (int ks = 0; ks < 4; ks++) {
            const bf16x8 aw = *(const LAS bf16x8*)(sb + G2_W + ((16 * i + fr) * 136 + 32 * ks + 8 * fq) * 2);
            const bf16x8 aq = *(const LAS bf16x8*)(sb + G2_Q + ((16 * i + fr) * 136 + 32 * ks + 8 * fq) * 2);
            const bf16x8 bS = *(const LAS bf16x8*)(SBuf + e_loc * 136 + 32 * ks + 8 * fq);
            aP = mfma16(aw, bS, aP);
            aO = mfma16(aq, bS, aO);
        }
        {
            const bf16x4 u = *(const LAS bf16x4*)(sb + G2_U + (e_loc * 72 + 16 * i + 4 * fq) * 2);
            float uf[4];
            unpack4(u, uf);
            if (MODE == 1) { uf[0] = 0.f; uf[1] = 0.f; uf[2] = 0.f; uf[3] = 0.f; }
            f32x4 vn;
#pragma unroll
            for (int r = 0; r < 4; r++) vn[r] = uf[r] - aP[r];
            *(LAS u32x2*)(VN + e_loc * 72 + 16 * i + 4 * fq) = pack4(vn);
        }
        lds_barrier();
        bf16x8 bV[2];
#pragma unroll
        for (int ks = 0; ks < 2; ks++) bV[ks] = *(const LAS bf16x8*)(VN + e_loc * 72 + 32 * ks + 8 * fq);
#pragma unroll
        for (int ks = 0; ks < 2; ks++) {
            const bf16x8 aa = *(const LAS bf16x8*)(sb + G2_A + ((16 * i + fr) * 72 + 32 * ks + 8 * fq) * 2);
            aO = mfma16(aa, bV[ks], aO);
        }
        {
            const size_t row0 = (size_t)(b * 128 + c) * 64;
            bf16_t* od = PROJ + (row0 + (e >> 1)) * LDP + QKV0 + 2048 + h * 128 + (e & 1) * 64 + 16 * i + 4 * fq;
            if (DRY) od = (bf16_t*)((char*)p->out + 52428800 + (((size_t)((char*)od - (char*)PROJ)) & 0x7ffff8));
            if (MODE == 1) {
                bf16_t* oi = (bf16_t*)((char*)p->out + OUT_OI_OFF) + ((size_t)((c - 64) * 16 + bh) * 64 + 16 * i + 4 * fq) * 128 + es * 32 + e_loc;
#pragma unroll
                for (int r = 0; r < 4; r++) oi[r * 128] = f2bf(aO[r]);
            } else if (DRY == 2) sink += aO[0] + aO[1] + aO[2] + aO[3]; else *(u32x2*)od = pack4(aO);
        }
        const float gl = GL[slot];
        S0 *= gl; S1 *= gl;
#pragma unroll
        for (int ks = 0; ks < 2; ks++) {
            const bf16x8 k0 = *(const LAS bf16x8*)(sb + G2_K + ((16 * dt0 + fr) * 72 + 32 * ks + 8 * fq) * 2);
            const bf16x8 k1 = *(const LAS bf16x8*)(sb + G2_K + ((16 * (dt0 + 1) + fr) * 72 + 32 * ks + 8 * fq) * 2);
            S0 = mfma16(k0, bV[ks], S0);
            S1 = mfma16(k1, bV[ks], S1);
        }
        *(LAS u32x2*)(SBuf + e_loc * 136 + 16 * dt0 + 4 * fq) = pack4(S0);
        *(LAS u32x2*)(SBuf + e_loc * 136 + 16 * (dt0 + 1) + 4 * fq) = pack4(S1);
        lds_barrier();
    };
    for (int c = c0; c < c0 + 64; c += 4) { step(c, R1, R0); step(c + 1, R2, R1); step(c + 2, R3, R2); step(c + 3, R0, R3); }
    if (MODE == 0 && c0 == 0) {
        bf16_t* sd = (bf16_t*)(p->ws + OFF_S64) + ((size_t)bh * 128 + e) * 128 + 4 * fq;
        *(u32x2*)(sd + 16 * dt0) = pack4(S0);
        *(u32x2*)(sd + 16 * (dt0 + 1)) = pack4(S1);
    }
    if (DRY == 2) *(float*)((char*)p->out + 52428800 + (size_t)(blockIdx.x * NTHR + tid) * 4) = sink;
}

constexpr int S2_SLOT0 = 34816, S2_SLOTB = 54784;
constexpr int S2_C = 0, S2_B = 17408, S2_X = 35840, S2_Y = 45056, S2_E = 54272;
struct SsdStage { u32x4 r[6]; float el; };

template <int DRY>
__device__ __forceinline__ void ssd_scan2(PP p, const int bh, const int c0) {
    LAS char* lb = (LAS char*)dsm;
    asm volatile("" : "+v"(lb));
    LAS bf16_t* HT = (LAS bf16_t*)lb;
    const int tid = tid_opaque(), lane = tid & 63, wid = __builtin_amdgcn_readfirstlane(tid >> 6), fr = lane & 15, fq = lane >> 4;
    bf16_t* PROJ = (bf16_t*)(p->ws + OFF_PROJ);
    const float* SMALL = (const float*)(p->ws + OFF_SMALL);
    bf16_t* YPART = (bf16_t*)(p->ws + OFF_YPART);
    const int b = bh >> 4, hh = bh & 15, g = hh >> 3;
    for (int idx = tid; idx < 64 * 136 / 2; idx += NTHR) ((LAS unsigned*)HT)[idx] = 0u;
    const int lr = tid >> 4, c16 = tid & 15, r8 = tid >> 3, c8 = tid & 7;
    const size_t rowb = (size_t)(b * 128) * 64;
    const char* gC = (const char*)PROJ + ((rowb + lr) * LDP + XBC0 + 1280 + g * 128) * 2 + c16 * 16;
    const char* gB = (const char*)PROJ + ((rowb + lr) * LDP + XBC0 + 1024 + g * 128) * 2 + c16 * 16;
    const char* gX = (const char*)PROJ + ((rowb + r8) * LDP + XBC0 + hh * 64) * 2 + c8 * 16;
    const char* gY = (const char*)YPART + ((rowb + r8) * 1024 + hh * 64) * 2 + c8 * 16;
    const float* gE = SMALL + (rowb + (tid & 63)) * 32 + hh;
    const unsigned dC = (unsigned)(lr * 136 + c16 * 8) * 2;
    const unsigned dB = (unsigned)((2 * lr + (c16 >> 3)) * 72 + (c16 & 7) * 8) * 2;
    const unsigned dX = (unsigned)(r8 * 72 + c8 * 8) * 2;
    auto issue = [&](int c, SsdStage& st) {
        c = c > c0 + 63 ? c0 + 63 : c;
        if (DRY == 3) c = 0;
        const size_t co = (size_t)((DRY == 4) ? 0 : c) * 64 * LDP * 2;
#pragma unroll
        for (int j = 0; j < 2; j++) st.r[j] = *(const u32x4*)(gC + co + (size_t)j * 32 * LDP * 2);
#pragma unroll
        for (int j = 0; j < 2; j++) st.r[2 + j] = *(const u32x4*)(gB + co + (size_t)j * 32 * LDP * 2);
        st.r[4] = *(const u32x4*)(gX + co);
        st.r[5] = *(const u32x4*)(gY + (size_t)c * 64 * 2048);
        st.el = gE[(size_t)c * 64 * 32];
    };
    auto commit = [&](const SsdStage& st, int slot) {
        LAS char* sb = lb + S2_SLOT0 + slot * S2_SLOTB;
#pragma unroll
        for (int j = 0; j < 2; j++) *(LAS u32x4*)(sb + S2_C + dC + j * 32 * 272) = st.r[j];
#pragma unroll
        for (int j = 0; j < 2; j++) *(LAS u32x4*)(sb + S2_B + dB + j * 64 * 144) = st.r[2 + j];
        *(LAS u32x4*)(sb + S2_X + dX) = st.r[4];
        *(LAS u32x4*)(sb + S2_Y + dX) = st.r[5];
        if (tid < 64) *(LAS float*)(sb + S2_E + tid * 4) = st.el;
    };
    const int i = wid & 3, ptb = 2 * (wid >> 2);
    f32x4 hs[4];
#pragma unroll
    for (int c = 0; c < 4; c++) hs[c] = (f32x4){0.f, 0.f, 0.f, 0.f};
    float sink = 0.f;
    SsdStage R0, R1, R2, R3;
    issue(c0, R0);
    commit(R0, 0);
    issue(c0 + 1, R1); issue(c0 + 2, R2); issue(c0 + 3, R3);
    float cum = 1.f;
    lds_barrier();
    auto step = [&](const int c, SsdStage& R, SsdStage& RI) {
        const int slot = c & 1;
        LAS char* sb = lb + S2_SLOT0 + slot * S2_SLOTB;
        commit(R, slot ^ 1);
        issue(c + 4, RI);
        const LAS bf16_t* Hc = HT + slot * 8704;
        LAS bf16_t* Hn = HT + (slot ^ 1) * 8704;
        const size_t row0 = (size_t)(b * 128 + c) * 64;
        const float elc = *(const LAS float*)(sb + S2_E + (16 * i + fr) * 4);
        const float dec = *(const LAS float*)(sb + S2_E + 63 * 4);
        if (c0 == 64) { if (tid == 0) ((float*)(p->ws + OFF_CUM))[bh * 64 + (c - 64)] = cum; cum *= dec; }
#pragma unroll
        for (int tt = 0; tt < 2; tt++) {
            const int pt = ptb + tt;
            f32x4 a = {0.f, 0.f, 0.f, 0.f};
#pragma unroll
            for (int ks = 0; ks < 4; ks++) {
                const bf16x8 cB = *(const LAS bf16x8*)(sb + S2_C + ((16 * i + fr) * 136 + 32 * ks + 8 * fq) * 2);
                const bf16x8 hf = *(const LAS bf16x8*)(Hc + (16 * pt + fr) * 136 + 32 * ks + 8 * fq);
                a = mfma16(hf, cB, a);
            }
            const bf16x4 yp = *(const LAS bf16x4*)(sb + S2_Y + ((16 * i + fr) * 72 + 16 * pt + 4 * fq) * 2);
            float yf[4];
            unpack4(yp, yf);
            f32x4 y;
#pragma unroll
            for (int r = 0; r < 4; r++) y[r] = yf[r] + elc * a[r];
            bf16_t* yd = YPART + (row0 + 16 * i + fr) * 1024 + hh * 64 + 16 * pt + 4 * fq;
            if (DRY) yd = (bf16_t*)((char*)p->out + 52428800 + (((size_t)((char*)yd - (char*)YPART)) & 0x7ffff8));
            if (DRY == 2) sink += y[0] + y[1] + y[2] + y[3]; else *(u32x2*)yd = pack4(y);
        }
#pragma unroll
        for (int pt = 0; pt < 4; pt++) {
            hs[pt] *= dec;
#pragma unroll
            for (int ks = 0; ks < 2; ks++) {
                const bf16x8 bA = *(const LAS bf16x8*)(sb + S2_B + ((16 * wid + fr) * 72 + 32 * ks + 8 * fq) * 2);
                const bf16x8 xB = *(const LAS bf16x8*)(sb + S2_X + ((16 * pt + fr) * 72 + 32 * ks + 8 * fq) * 2);
                hs[pt] = mfma16(bA, xB, hs[pt]);
            }
            *(LAS u32x2*)(Hn + (16 * pt + fr) * 136 + 16 * wid + 4 * fq) = pack4(hs[pt]);
        }
        lds_barrier();
    };
    for (int c = c0; c < c0 + 64; c += 4) { step(c, R1, R0); step(c + 1, R2, R1); step(c + 2, R3, R2); step(c + 3, R0, R3); }
    if (c0 == 0) {
        bf16_t* hd = (bf16_t*)(p->ws + OFF_H64) + (size_t)bh * 64 * 128 + 16 * wid + 4 * fq;
#pragma unroll
        for (int pt = 0; pt < 4; pt++) *(u32x2*)(hd + (16 * pt + fr) * 128) = pack4(hs[pt]);
    }
    if (DRY == 2) *(float*)((char*)p->out + 52428800 + (size_t)(blockIdx.x * NTHR + tid) * 4) = sink;
}

template <int DRY>
__device__ __forceinline__ void phase_c(PP p) {
    for (int it = blockIdx.x; it < 256; it += gridDim.x) {
        if (it < 192) {
            const int r = it & 63, role = it >> 6;
            const int bh = (r & 7) + 8 * ((r >> 3) >> 2), es = (r >> 3) & 3;
            if (role == 0) gdn_scan2<DRY, 0>(p, bh, es, 0);
            else if (role == 1) gdn_scan2<DRY, 0>(p, bh, es, 64);
            else gdn_scan2<DRY, 1>(p, bh, es, 64);
        } else {
            const int r = it - 192, combo = r & 7, hl = r >> 3;
            ssd_scan2<DRY>(p, (combo >> 2) * 16 + ((combo >> 1) & 1) * 8 + hl, (combo & 1) * 64);
        }
        __syncthreads();
    }
}

template <int DRY>
__device__ __forceinline__ void phase_fix(PP p) {
    const int tid = tid_opaque(), lane = tid & 63, wid = tid >> 6, fr = lane & 15, fq = lane >> 4;
    bf16_t* PROJ = (bf16_t*)(p->ws + OFF_PROJ);
    const float* SMALL = (const float*)(p->ws + OFF_SMALL);
    bf16_t* YPART = (bf16_t*)(p->ws + OFF_YPART);
    struct SF { bf16x8 hA[2][4]; bf16x4 y4[2]; float sc; };
    const int i = wid & 3, ptb = 2 * (wid >> 2);
    for (int gi = blockIdx.x; gi < 256; gi += gridDim.x) {
        const int b = gi >> 7, g = (gi >> 6) & 1, cc = gi & 63;
        const size_t row0 = (size_t)(b * 128 + 64 + cc) * 64;
        const bf16_t* crow = PROJ + (row0 + 16 * i + fr) * LDP + XBC0 + 1280 + g * 128 + 8 * fq;
        bf16x8 cB[4];
#pragma unroll
        for (int ks = 0; ks < 4; ks++) cB[ks] = *(const bf16x8*)(crow + 32 * ks);
        auto sload = [&](int hl, SF& f) {
            const int hh = 8 * g + hl, bh = b * 16 + hh;
            f.sc = SMALL[(row0 + 16 * i + fr) * 32 + hh] * ((const float*)(p->ws + OFF_CUM))[bh * 64 + cc];
#pragma unroll
            for (int tt = 0; tt < 2; tt++) {
                const bf16_t* hp = (const bf16_t*)(p->ws + OFF_H64) + ((size_t)bh * 64 + 16 * (ptb + tt) + fr) * 128 + 8 * fq;
#pragma unroll
                for (int ks = 0; ks < 4; ks++) f.hA[tt][ks] = *(const bf16x8*)(hp + 32 * ks);
                f.y4[tt] = *(const bf16x4*)(YPART + (row0 + 16 * i + fr) * 1024 + hh * 64 + 16 * (ptb + tt) + 4 * fq);
            }
        };
        auto sfinish = [&](int hl, const SF& f) {
            const int hh = 8 * g + hl;
#pragma unroll
            for (int tt = 0; tt < 2; tt++) {
                f32x4 acc = {0.f, 0.f, 0.f, 0.f};
#pragma unroll
                for (int ks = 0; ks < 4; ks++) acc = mfma16(f.hA[tt][ks], cB[ks], acc);
                float yf[4];
                unpack4(f.y4[tt], yf);
                f32x4 y;
#pragma unroll
                for (int r = 0; r < 4; r++) y[r] = yf[r] + f.sc * acc[r];
                *(u32x2*)(YPART + (row0 + 16 * i + fr) * 1024 + hh * 64 + 16 * (ptb + tt) + 4 * fq) = pack4(y);
            }
        };
        SF fa, fb;
        sload(0, fa);
#pragma unroll
        for (int hl = 0; hl < 8; hl += 2) {
            sload(hl + 1, fb);
            sfinish(hl, fa);
            if (hl + 2 < 8) sload(hl + 2, fa);
            sfinish(hl + 1, fb);
        }
    }
}

template <int DRY>
__device__ __forceinline__ void phase_d1(PP p) {
    const int tid = tid_opaque(), lane = tid & 63, wid = tid >> 6;
    bf16_t* PROJ = (bf16_t*)(p->ws + OFF_PROJ);
    const bf16_t* YPART = (const bf16_t*)(p->ws + OFF_YPART);
    {
        LAS bf16_t* YL = (LAS bf16_t*)dsm;
        const float* SMALL = (const float*)(p->ws + OFF_SMALL);
        const int fr = lane & 15, fq = lane >> 4, i4 = wid & 3, ptb = 2 * (wid >> 2);
        struct SF { bf16x8 hA[2][4]; bf16x4 y4[2]; float sc; };
        for (int gi = blockIdx.x; gi < 512; gi += gridDim.x) {
            const int k = gi >> 8, j = gi & 255, b = k, g = j >> 7, c = (j & 127) ^ (k << 6);
            const size_t row0 = (size_t)(b * 128 + c) * 64;
            const bool fix = c >= 64;
            bf16x8 yv[8], zv[8];
#pragma unroll
            for (int t8 = 0; t8 < 8; t8++) {
                const size_t tok = row0 + wid * 8 + t8;
                zv[t8] = *(const bf16x8*)(PROJ + tok * LDP + g * 512 + lane * 8);
                if (!fix) yv[t8] = *(const bf16x8*)(YPART + tok * 1024 + g * 512 + lane * 8);
            }
            if (fix) {
                const int cc = c - 64;
                const bf16_t* crow = PROJ + (row0 + 16 * i4 + fr) * LDP + XBC0 + 1280 + g * 128 + 8 * fq;
                bf16x8 cB[4];
#pragma unroll
                for (int ks = 0; ks < 4; ks++) cB[ks] = *(const bf16x8*)(crow + 32 * ks);
                auto sload = [&](int hl, SF& f) {
                    const int hh = 8 * g + hl, bh = b * 16 + hh;
                    f.sc = SMALL[(row0 + 16 * i4 + fr) * 32 + hh] * ((const float*)(p->ws + OFF_CUM))[bh * 64 + cc];
#pragma unroll
                    for (int tt = 0; tt < 2; tt++) {
                        const bf16_t* hp = (const bf16_t*)(p->ws + OFF_H64) + ((size_t)bh * 64 + 16 * (ptb + tt) + fr) * 128 + 8 * fq;
#pragma unroll
                        for (int ks = 0; ks < 4; ks++) f.hA[tt][ks] = *(const bf16x8*)(hp + 32 * ks);
                        f.y4[tt] = *(const bf16x4*)(YPART + (row0 + 16 * i4 + fr) * 1024 + hh * 64 + 16 * (ptb + tt) + 4 * fq);
                    }
                };
                auto sfinish = [&](int hl, const SF& f) {
#pragma unroll
                    for (int tt = 0; tt < 2; tt++) {
                        f32x4 acc = {0.f, 0.f, 0.f, 0.f};
#pragma unroll
                        for (int ks = 0; ks < 4; ks++) acc = mfma16(f.hA[tt][ks], cB[ks], acc);
                        float yf[4];
                        unpack4(f.y4[tt], yf);
                        f32x4 y;
#pragma unroll
                        for (int r = 0; r < 4; r++) y[r] = yf[r] + f.sc * acc[r];
                        *(LAS u32x2*)(YL + (16 * i4 + fr) * 520 + hl * 64 + 16 * (ptb + tt) + 4 * fq) = pack4(y);
                    }
                };
                SF fa, fb;
                sload(0, fa);
#pragma unroll
                for (int hl = 0; hl < 8; hl += 2) {
                    sload(hl + 1, fb);
                    sfinish(hl, fa);
                    if (hl + 2 < 8) sload(hl + 2, fa);
                    sfinish(hl + 1, fb);
                }
                __syncthreads();
#pragma unroll
                for (int t8 = 0; t8 < 8; t8++) yv[t8] = *(const LAS bf16x8*)(YL + (wid * 8 + t8) * 520 + lane * 8);
            }
            const float4 w0 = *(const float4*)(p->ssd_norm_w + g * 512 + lane * 8), w1 = *(const float4*)(p->ssd_norm_w + g * 512 + lane * 8 + 4);
#pragma unroll
            for (int t8 = 0; t8 < 8; t8++) {
                const size_t tok = row0 + wid * 8 + t8;
                float y[8], z[8], v[8];
                unpack8(yv[t8], y); unpack8(zv[t8], z);
                float ss = 0.f;
#pragma unroll
                for (int i = 0; i < 8; i++) { v[i] = y[i] * silu_f(z[i]); ss += v[i] * v[i]; }
                ss = wave_sum(ss);
                const float rs = rsqrtf(ss * (1.f / 512.f) + 1e-6f);
                v[0] *= rs * w0.x; v[1] *= rs * w0.y; v[2] *= rs * w0.z; v[3] *= rs * w0.w;
                v[4] *= rs * w1.x; v[5] *= rs * w1.y; v[6] *= rs * w1.z; v[7] *= rs * w1.w;
                if (DRY) *(u32x4*)((char*)p->out + (((tok * LDP + XBC0 + g * 512 + lane * 8) * 2) & 0x3fffff0)) = pack8(v);
                else *(u32x4*)(PROJ + tok * LDP + XBC0 + g * 512 + lane * 8) = pack8(v);
            }
            if (fix) __syncthreads();
        }
    }
    LAS float* OT = (LAS float*)dsm;
    struct D1In { bf16x8 a, b; unsigned gg[8]; };
    auto d1load = [&](int it, D1In& in) {
        const int ch = it >> 3, h = it & 7;
        const size_t row0 = (size_t)ch * 64;
        const int e = tid >> 2, lq = tid & 3;
        const bf16_t* src = PROJ + (row0 + (e >> 1)) * LDP + QKV0 + 2048 + h * 128 + (e & 1) * 64 + lq * 16;
        in.a = *(const bf16x8*)src; in.b = *(const bf16x8*)(src + 8);
#pragma unroll
        for (int tk = 0; tk < 8; tk++) in.gg[tk] = *(const unsigned*)(PROJ + (row0 + wid * 8 + tk) * LDP + GATE0 + h * 128 + 2 * lane);
    };
    D1In cur, nxt;
    if ((int)blockIdx.x < 2048) d1load(blockIdx.x, cur);
    nxt = cur;
    const float w0 = p->gdn_norm_w[2 * lane], w1 = p->gdn_norm_w[2 * lane + 1];
    for (int it = blockIdx.x; it < 2048; it += gridDim.x) {
        const int ch = it >> 3, h = it & 7;
        const size_t row0 = (size_t)ch * 64;
        {
            const int e = tid >> 2, lq = tid & 3;
            float fa[8], fb[8];
            unpack8(cur.a, fa); unpack8(cur.b, fb);
#pragma unroll
            for (int t = 0; t < 8; t++) { OT[(lq * 16 + t) * 129 + e] = fa[t]; OT[(lq * 16 + 8 + t) * 129 + e] = fb[t]; }
        }
        const bool fix = (ch & 127) >= 64;
        bf16x8 fS[4], fI[4][4];
        if (fix) {
            const int fr = lane & 15, fq = lane >> 4, bh = (ch >> 7) * 8 + h, cc = (ch & 127) - 64;
            const bf16_t* sp = (const bf16_t*)(p->ws + OFF_S64) + ((size_t)bh * 128 + 16 * wid + fr) * 128 + 8 * fq;
            const bf16_t* oi = (const bf16_t*)((const char*)p->out + OUT_OI_OFF) + ((size_t)(cc * 16 + bh) * 64 + fr) * 128 + 8 * fq;
#pragma unroll
            for (int ks = 0; ks < 4; ks++) fS[ks] = *(const bf16x8*)(sp + 32 * ks);
#pragma unroll
            for (int lt = 0; lt < 4; lt++)
#pragma unroll
                for (int ks = 0; ks < 4; ks++) fI[lt][ks] = *(const bf16x8*)(oi + (size_t)(16 * lt) * 128 + 32 * ks);
        }
        if (it + (int)gridDim.x < 2048) d1load(it + gridDim.x, nxt);
        __syncthreads();
        if (fix) {
            const int fr = lane & 15, fq = lane >> 4;
#pragma unroll
            for (int lt = 0; lt < 4; lt++) {
                f32x4 acc = {0.f, 0.f, 0.f, 0.f};
#pragma unroll
                for (int ks = 0; ks < 4; ks++) acc = mfma16(fI[lt][ks], fS[ks], acc);
#pragma unroll
                for (int r = 0; r < 4; r++) OT[(16 * lt + 4 * fq + r) * 129 + 16 * wid + fr] += acc[r];
            }
            __syncthreads();
        }
#pragma unroll
        for (int tk = 0; tk < 8; tk++) {
            const int l = wid * 8 + tk;
            const float o0 = OT[l * 129 + 2 * lane], o1 = OT[l * 129 + 2 * lane + 1];
            const float ss = wave_sum(o0 * o0 + o1 * o1);
            const float rs = rsqrtf(ss * (1.f / 128.f) + 1e-6f);
            const unsigned gg = cur.gg[tk];
            const float r0 = o0 * rs * w0 * silu_f(bflo(gg)), r1 = o1 * rs * w1 * silu_f(bfhi(gg));
            if (DRY) *(unsigned*)((char*)p->out + ((((row0 + l) * LDP + QKV0 + 2048 + h * 128 + 2 * lane) * 2) & 0x3fffffc)) = pk2(r0, r1);
            else *(unsigned*)(PROJ + (row0 + l) * LDP + QKV0 + 2048 + h * 128 + 2 * lane) = pk2(r0, r1);
        }
        __syncthreads();
        cur = nxt;
    }
}

__device__ __forceinline__ void phase_final(PP p) {
    const int tid = tid_opaque(), lane = tid & 63, wid = tid >> 6;
    for (int r0 = (blockIdx.x * 8 + wid) * 4; r0 < MTOK; r0 += gridDim.x * 32) {
        float4 v[4][4];
#pragma unroll
        for (int rr = 0; rr < 4; rr++) {
            const float4* xr = (const float4*)(p->out + (size_t)(r0 + rr) * DM);
#pragma unroll
            for (int i = 0; i < 4; i++) v[rr][i] = xr[lane + 64 * i];
        }
#pragma unroll
        for (int rr = 0; rr < 4; rr++) {
            float4* xr = (float4*)(p->out + (size_t)(r0 + rr) * DM);
            float ss = 0.f;
#pragma unroll
            for (int i = 0; i < 4; i++) ss += v[rr][i].x * v[rr][i].x + v[rr][i].y * v[rr][i].y + v[rr][i].z * v[rr][i].z + v[rr][i].w * v[rr][i].w;
            ss = wave_sum(ss);
            const float rs = rsqrtf(ss * (1.f / DM) + 1e-6f);
#pragma unroll
            for (int i = 0; i < 4; i++) {
                const float4 w = ((const float4*)p->final_norm_w)[lane + 64 * i];
                xr[lane + 64 * i] = make_float4(v[rr][i].x * rs * w.x, v[rr][i].y * rs * w.y, v[rr][i].z * rs * w.z, v[rr][i].w * rs * w.w);
            }
        }
    }
}

#define LAUNDER asm volatile("" : "+s"(p))
#ifndef PROG
#define PROG {0, 1, 2, 3, 4, 5}
#endif
constexpr int kProg[] = PROG;
constexpr int kProgLen = sizeof(kProg) / sizeof(int);

template <int PH>
__device__ __forceinline__ void run_phase(PP p, unsigned& bk) {
    if constexpr (PH == 0) phase_prep(p, true);
    else if constexpr (PH == 20) phase_prep(p, false);
    else if constexpr (PH == 1) phase_gemm<1>(p, bk);
    else if constexpr (PH == 2) phase_b<0>(p);
    else if constexpr (PH == 15) { }
    else if constexpr (PH == 12) phase_b<12>(p);
    else if constexpr (PH == 13) phase_b<13>(p);
    else if constexpr (PH == 14) phase_b<14>(p);
    else if constexpr (PH == 17) phase_b<17>(p);
    else if constexpr (PH == 18) phase_b<18>(p);
    else if constexpr (PH == 3) phase_c<0>(p);
    else if constexpr (PH == 7) phase_c<1>(p);
    else if constexpr (PH == 8) phase_c<2>(p);
    else if constexpr (PH == 9) phase_c<3>(p);
    else if constexpr (PH == 10) phase_c<4>(p);
    else if constexpr (PH == 11) phase_c<5>(p);
    else if constexpr (PH == 24) phase_fix<0>(p);
    else if constexpr (PH == 4) phase_d1<0>(p);
    else if constexpr (PH == 16) phase_d1<1>(p);
    else if constexpr (PH == 5) phase_gemm<2>(p, bk);
    else phase_final(p);
}
template <int I>
__device__ __forceinline__ void run_prog(PP p, cg::grid_group& grid, unsigned& bk) {
    if constexpr (I < kProgLen) {
        if (I > 0) {
            if ((gridDim.x & 7u) == 0u) fast_grid_barrier((unsigned*)(p->ws + OFF_BAR), bk);
            else grid.sync();
        }
        LAUNDER;
        run_phase<kProg[I]>(p, bk);
        run_prog<I + 1>(p, grid, bk);
    }
}

template <int LO, int HI>
__global__ void __launch_bounds__(512) hybrid_mega(Params p_arg) {
    cg::grid_group grid = cg::this_grid();
    PP p = (PP)__builtin_amdgcn_kernarg_segment_ptr();
    unsigned bk = 0u;
    if constexpr (LO == 0 && HI == 6) run_prog<0>(p, grid, bk);
    else { LAUNDER; run_phase<LO>(p, bk); }
}

template <int PH>
static void launch_one(const Params& p, int grid_blocks, hipStream_t stream) {
    hipFuncSetAttribute((const void*)hybrid_mega<PH, PH>, hipFuncAttributeMaxDynamicSharedMemorySize, LDS_BYTES);
    hipLaunchKernelGGL((hybrid_mega<PH, PH>), dim3(grid_blocks), dim3(NTHR), LDS_BYTES, stream, p);
}

extern "C" void kernel_launch(void* const* d_in, const int* in_sizes, int n_in, void* d_out, int out_size, void* d_ws, size_t ws_size,
                              hipStream_t stream) {
    static int grid_blocks = 0;
    if (grid_blocks == 0) {
        int dev = 0, cus = 0, per_cu = 0;
        (void)hipGetDevice(&dev);
        (void)hipDeviceGetAttribute(&cus, hipDeviceAttributeMultiprocessorCount, dev);
#if N_LAUNCH_MODE == 1
        (void)hipFuncSetAttribute((const void*)hybrid_mega<0, 6>, hipFuncAttributeMaxDynamicSharedMemorySize, LDS_BYTES);
        (void)hipOccupancyMaxActiveBlocksPerMultiprocessor(&per_cu, (const void*)hybrid_mega<0, 6>, NTHR, LDS_BYTES);
#else
        per_cu = 1;
#endif
        if (per_cu < 1) { fprintf(stderr, "occupancy query returned %d\n", per_cu); per_cu = 1; }
        if (per_cu > 1) per_cu = 1;
        grid_blocks = cus * per_cu;
        if (ws_size < WS_NEED) fprintf(stderr, "workspace too small: %zu < %zu\n", ws_size, (size_t)WS_NEED);
    }
    Params p{};
    p.x = (const float*)d_in[0]; p.norm_w = (const float*)d_in[1]; p.w_in = (const float*)d_in[2];
    p.ssd_conv_w = (const float*)d_in[3]; p.ssd_conv_b = (const float*)d_in[4]; p.ssd_dt_bias = (const float*)d_in[5];
    p.ssd_a_log = (const float*)d_in[6]; p.ssd_d = (const float*)d_in[7]; p.ssd_norm_w = (const float*)d_in[8];
    p.gdn_conv_w = (const float*)d_in[9]; p.gdn_dt_bias = (const float*)d_in[10]; p.gdn_a_log = (const float*)d_in[11];
    p.gdn_norm_w = (const float*)d_in[12]; p.w_out = (const float*)d_in[13]; p.final_norm_w = (const float*)d_in[14];
    p.out = (float*)d_out; p.ws = (char*)d_ws;
#if N_LAUNCH_MODE == 1
    (void)hipMemsetAsync((char*)d_ws + OFF_BAR, 0, BAR_BYTES, stream);
    void* args[] = {&p};
    hipError_t e = hipLaunchCooperativeKernel((const void*)hybrid_mega<0, 6>, dim3(grid_blocks), dim3(NTHR), args, LDS_BYTES, stream);
    if (e != hipSuccess) fprintf(stderr, "cooperative launch failed: %s (grid %d)\n", hipGetErrorString(e), grid_blocks);
#else
    launch_one<0>(p, grid_blocks, stream); launch_one<1>(p, grid_blocks, stream);
    launch_one<2>(p, grid_blocks, stream);
#ifndef SKIP_MID
    launch_one<3>(p, grid_blocks, stream);
#endif
    launch_one<4>(p, grid_blocks, stream);
    launch_one<5>(p, grid_blocks, stream);
    launch_one<6>(p, grid_blocks, stream);
#endif
}
```

```cpp
#include <hip/hip_runtime.h>
#include <hip/hip_cooperative_groups.h>
#include <cstdio>
namespace cg = cooperative_groups;

typedef unsigned short bf16_t;
typedef short bf16x8 __attribute__((ext_vector_type(8)));
typedef short bf16x4 __attribute__((ext_vector_type(4)));
typedef float f32x4 __attribute__((ext_vector_type(4)));
typedef unsigned u32x4 __attribute__((ext_vector_type(4)));
typedef unsigned u32x2 __attribute__((ext_vector_type(2)));

#ifndef N_LAUNCH_MODE
#define N_LAUNCH_MODE 1
#endif

constexpr int NTHR = 512;
constexpr int MTOK = 16384, DM = 1024, LDP = 6656;
constexpr int XBC0 = 1024, GATE0 = 2560, QKV0 = 3584;
constexpr size_t OFF_PROJ = 0;
constexpr size_t OFF_SMALL = OFF_PROJ + (size_t)MTOK * LDP * 2;
constexpr size_t OFF_HALO = OFF_SMALL + (size_t)MTOK * 32 * 4;
constexpr size_t OFF_WOUT = OFF_HALO + (size_t)256 * 3 * 4608 * 2;
constexpr size_t OFF_WIN = OFF_WOUT + (size_t)1024 * 2048 * 2;
constexpr size_t OFF_YPART = OFF_WIN;
constexpr size_t OFF_BAR = OFF_YPART + (size_t)MTOK * 1024 * 2;
constexpr int BAR_BYTES = (19 + 64) * 256;
constexpr size_t OFF_ROWSS = OFF_BAR + BAR_BYTES;
constexpr size_t OFF_S64 = OFF_ROWSS + (size_t)4 * MTOK * 4;
constexpr size_t OFF_H64 = OFF_S64 + (size_t)16 * 128 * 128 * 2;
constexpr size_t OFF_CUM = OFF_H64 + (size_t)32 * 64 * 128 * 2;
constexpr size_t WS_NEED = OFF_CUM + (size_t)32 * 64 * 4;
constexpr size_t OUT_OI_OFF = 50331648;
constexpr size_t OUT_ATTN_OFF = 33554432;
constexpr int LDS_BYTES = 147968;

struct Params {
    const float *x, *norm_w, *w_in, *ssd_conv_w, *ssd_conv_b, *ssd_dt_bias, *ssd_a_log, *ssd_d, *ssd_norm_w,
        *gdn_conv_w, *gdn_dt_bias, *gdn_a_log, *gdn_norm_w, *w_out, *final_norm_w;
    float* out;
    char* ws;
};

#define LAS __attribute__((address_space(3)))
typedef const __attribute__((address_space(4))) Params* PP;

extern __shared__ __attribute__((aligned(16))) char dsm[];

typedef float f32x2 __attribute__((ext_vector_type(2)));
typedef __bf16 bf16x2v __attribute__((ext_vector_type(2)));
__device__ __forceinline__ unsigned pk2(float lo, float hi) {
    const f32x2 v = {lo, hi};
    const bf16x2v b = __builtin_convertvector(v, bf16x2v);
    return __builtin_bit_cast(unsigned, b);
}
__device__ __forceinline__ bf16_t f2bf(float f) { return (bf16_t)(pk2(f, 0.f) & 0xffffu); }
__device__ __forceinline__ float bf2f(bf16_t h) { return __uint_as_float(((unsigned)h) << 16); }
__device__ __forceinline__ float bflo(unsigned u) { return __uint_as_float(u << 16); }
__device__ __forceinline__ float bfhi(unsigned u) { return __uint_as_float(u & 0xffff0000u); }
__device__ __forceinline__ void unpack8(const bf16x8& v, float* f) {
    u32x4 u = __builtin_bit_cast(u32x4, v);
#pragma unroll
    for (int i = 0; i < 4; i++) { f[2 * i] = bflo(u[i]); f[2 * i + 1] = bfhi(u[i]); }
}
__device__ __forceinline__ void unpack4(const bf16x4& v, float* f) {
    u32x2 u = __builtin_bit_cast(u32x2, v);
    f[0] = bflo(u[0]); f[1] = bfhi(u[0]); f[2] = bflo(u[1]); f[3] = bfhi(u[1]);
}
__device__ __forceinline__ u32x4 pack8(const float* f) {
    u32x4 o; o[0] = pk2(f[0], f[1]); o[1] = pk2(f[2], f[3]); o[2] = pk2(f[4], f[5]); o[3] = pk2(f[6], f[7]);
    return o;
}
__device__ __forceinline__ u32x2 pack4(const f32x4& v) {
    u32x2 o; o[0] = pk2(v[0], v[1]); o[1] = pk2(v[2], v[3]);
    return o;
}
__device__ __forceinline__ float wave_sum(float v) {
#pragma unroll
    for (int o = 32; o > 0; o >>= 1) v += __shfl_xor(v, o, 64);
    return v;
}
__device__ __forceinline__ float wave_incl_scan(float v, int lane) {
#pragma unroll
    for (int o = 1; o < 64; o <<= 1) { float t = __shfl_up(v, o, 64); if (lane >= o) v += t; }
    return v;
}
__device__ __forceinline__ float softplus_f(float x) { return x > 20.f ? x : log1pf(expf(x)); }
__device__ __forceinline__ float silu_f(float x) { return x * __builtin_amdgcn_rcpf(1.f + __expf(-x)); }
__device__ __forceinline__ f32x4 mfma16(const bf16x8& a, const bf16x8& b, const f32x4& c) {
    return __builtin_amdgcn_mfma_f32_16x16x32_bf16(a, b, c, 0, 0, 0);
}
__device__ __forceinline__ int tid_opaque() {
    int t = threadIdx.x;
    asm volatile("" : "+v"(t));
    return t;
}
__device__ __forceinline__ unsigned gb_ld(unsigned* q) { return __hip_atomic_load(q, __ATOMIC_RELAXED, __HIP_MEMORY_SCOPE_AGENT); }
__device__ __forceinline__ unsigned gb_add(unsigned* q) { return __hip_atomic_fetch_add(q, 1u, __ATOMIC_RELAXED, __HIP_MEMORY_SCOPE_AGENT); }
__device__ __forceinline__ void fast_grid_barrier(unsigned* bw, unsigned& k) {
    asm volatile("s_waitcnt vmcnt(0)" ::: "memory");
    __syncthreads();
    if (threadIdx.x == 0) {
        const unsigned G = gridDim.x, g = blockIdx.x & 7u;
        const unsigned nloc = (G - g + 7u) >> 3, ngrp = G < 8u ? G : 8u;
        __builtin_amdgcn_fence(__ATOMIC_RELEASE, "agent");
        asm volatile("s_waitcnt vmcnt(0)" ::: "memory");
        unsigned* sub = bw + 64 * (1 + g);
        unsigned* gen = bw + 64 * (9 + g);
        unsigned* top = bw + 64 * 17;
        unsigned* topgen = bw + 64 * 18;
        const unsigned old = gb_add(sub);
        if (old + 1u == (k + 1u) * nloc) {
            const unsigned og = gb_add(top);
            if (og + 1u == (k + 1u) * ngrp) gb_add(topgen);
            else while (gb_ld(topgen) == k) __builtin_amdgcn_s_sleep(1);
            gb_add(gen);
        } else {
            while (gb_ld(gen) == k) __builtin_amdgcn_s_sleep(1);
        }
        __builtin_amdgcn_fence(__ATOMIC_ACQUIRE, "agent");
        asm volatile("s_waitcnt vmcnt(0)" ::: "memory");
    }
    __syncthreads();
    k++;
}
__device__ __forceinline__ void lds_barrier() {
    asm volatile("s_waitcnt lgkmcnt(0)" ::: "memory");
    __builtin_amdgcn_s_barrier();
    asm volatile("" ::: "memory");
}

__device__ __forceinline__ int src_col(int n) {
    if (n < 2560) return n;
    if (n < 6656) return n + 16;
    if (n < 6672) return n - 6656 + 2560;
    if (n < 6688) return n;
    return -1;
}

__device__ __forceinline__ void phase_prep(PP p, const bool zero_bar) {
    LAS float* tile = (LAS float*)dsm;
    const int tid = tid_opaque(), lane = tid & 63, wid = tid >> 6;
    bf16_t* U = (bf16_t*)p->out;
    for (int r0 = (blockIdx.x * 8 + wid) * 4; r0 < MTOK; r0 += gridDim.x * 32) {
        float4 v[4][4];
#pragma unroll
        for (int rr = 0; rr < 4; rr++) {
            const float4* xr = (const float4*)(p->x + (size_t)(r0 + rr) * DM);
#pragma unroll
            for (int i = 0; i < 4; i++) v[rr][i] = xr[lane + 64 * i];
        }
#pragma unroll
        for (int rr = 0; rr < 4; rr++) {
            float ss = 0.f;
#pragma unroll
            for (int i = 0; i < 4; i++) ss += v[rr][i].x * v[rr][i].x + v[rr][i].y * v[rr][i].y + v[rr][i].z * v[rr][i].z + v[rr][i].w * v[rr][i].w;
            ss = wave_sum(ss);
            const float rs = rsqrtf(ss * (1.f / DM) + 1e-6f);
#pragma unroll
            for (int i = 0; i < 4; i++) {
                const float4 w = ((const float4*)p->norm_w)[lane + 64 * i];
                u32x2 o;
                o[0] = pk2(v[rr][i].x * rs * w.x, v[rr][i].y * rs * w.y);
                o[1] = pk2(v[rr][i].z * rs * w.z, v[rr][i].w * rs * w.w);
                *(u32x2*)(U + (size_t)(r0 + rr) * DM + (lane + 64 * i) * 4) = o;
            }
        }
    }
    bf16_t* WIN = (bf16_t*)(p->ws + OFF_WIN);
    bf16_t* WOUT = (bf16_t*)(p->ws + OFF_WOUT);
    auto tload = [&](int t, float (&val)[8]) {
        const bool isin = t < 1728;
        const int tt = isin ? t : t - 1728;
        const int ntile = isin ? tt / 16 : tt / 32, ktile = isin ? tt % 16 : tt % 32;
        const float* src = isin ? p->w_in : p->w_out;
        const int ld = isin ? 6688 : 1024;
#pragma unroll
        for (int it = 0; it < 8; it++) {
            const int e = tid + it * 512, r = e >> 6, c = e & 63, n = ntile * 64 + c;
            const int sc = isin ? src_col(n) : n;
            val[it] = 0.f;
            if (sc >= 0) val[it] = src[(size_t)(ktile * 64 + r) * ld + sc];
        }
    };
    float cur[8], nxt[8];
#pragma unroll
    for (int it = 0; it < 8; it++) { cur[it] = 0.f; nxt[it] = 0.f; }
    if (blockIdx.x < 1728 + 512) tload(blockIdx.x, cur);
    for (int t = blockIdx.x; t < 1728 + 512; t += gridDim.x) {
        const bool isin = t < 1728;
        const int tt = isin ? t : t - 1728;
        const int ntile = isin ? tt / 16 : tt / 32, ktile = isin ? tt % 16 : tt % 32;
        const int K = isin ? 1024 : 2048;
        bf16_t* dst = isin ? WIN : WOUT;
#pragma unroll
        for (int it = 0; it < 8; it++) {
            const int e = tid + it * 512, r = e >> 6, c = e & 63;
            tile[r * 65 + c] = cur[it];
        }
        if (t + (int)gridDim.x < 1728 + 512) tload(t + gridDim.x, nxt);
        __syncthreads();
        {
            const int c = tid >> 3, r0 = (tid & 7) * 8;
            float f[8];
#pragma unroll
            for (int i = 0; i < 8; i++) f[i] = tile[(r0 + i) * 65 + c];
            *(u32x4*)(dst + (size_t)(ntile * 64 + c) * K + ktile * 64 + r0) = pack8(f);
        }
        __syncthreads();
#pragma unroll
        for (int it = 0; it < 8; it++) cur[it] = nxt[it];
    }
}

constexpr int HT_ELEMS = 128 * 64;
__device__ __forceinline__ int lds_byte(int r, int c) {
    int st = (r >> 4) * 2 + (c >> 5), rr = r & 15, cc = c & 31, ob = rr * 64 + cc * 2;
    return st * 1024 + (ob ^ (((ob >> 9) & 1) << 5));
}
__device__ __forceinline__ int perm32(int rho) { const int n = rho >> 4, i = rho & 15; return 8 * (i >> 2) + 4 * n + (i & 3); }
__device__ __forceinline__ void stage_rc(int b, int& R, int& C) {
    int st = b / 1024, sb = b % 1024, swz = sb ^ (((sb >> 9) & 1) << 5);
    R = (st >> 1) * 16 + swz / 64;
    C = (st & 1) * 32 + (swz % 64) / 2;
}

template <int GID>
__device__ __forceinline__ void gemm_tile(PP p, const int tid, const int brow, const int bcol) {
    constexpr int K = (GID == 1) ? 1024 : 2048;
    constexpr int LDA = (GID == 1) ? 1024 : LDP;
    constexpr int HALF = 128;
    constexpr int HTB = 128 * 64 * 2;
    LAS unsigned char* lds = (LAS unsigned char*)dsm;
    const int wid = __builtin_amdgcn_readfirstlane(tid >> 6), lane = tid & 63, wr = wid >> 2, wc = wid & 3, fr = lane & 15, fq = lane >> 4;
    unsigned voffA[2], voffB[2];
#pragma unroll
    for (int i = 0; i < 2; ++i) {
        int R, C; stage_rc(tid * 16 + i * 8192, R, C);
        const int Rb = (R & ~31) + perm32(R & 31);
        voffA[i] = (unsigned)(R * LDA + C) * 2u; voffB[i] = (unsigned)(Rb * K + C) * 2u;
    }
    const char* Abase = (GID == 1) ? (const char*)p->out : (const char*)(p->ws + OFF_PROJ);
    const char* cA = Abase + (size_t)brow * LDA * 2;
    const char* cB = (const char*)(p->ws + (GID == 1 ? OFF_WIN : OFF_WOUT)) + (size_t)bcol * K * 2;
    constexpr size_t hstepA = (size_t)HALF * LDA * 2, hstepB = (size_t)HALF * K * 2;
    const unsigned ldsw = (unsigned)wid * 1024u;
    const int aoff = lds_byte(wr * 64 + fr, fq * 8), boff = lds_byte(wc * 32 + fr, fq * 8);
#define AKOFF(kt) ((GID == 1) ? (size_t)(kt) * 128 : ((kt) < 16 ? (size_t)(1024 + (kt) * 64) * 2 : (size_t)(5632 + ((kt) - 16) * 64) * 2))
#define BKOFF(kt) ((size_t)(kt) * 128)
#define SA(b, h) (((b) * 2 + (h)) * HTB)
#define SB(b, h) ((4 + (b) * 2 + (h)) * HTB)
#define STAGE(bufoff, gbase, voff)                                                                                  \
    do {                                                                                                           \
        _Pragma("unroll") for (int _i = 0; _i < 2; ++_i)                                                           \
            __builtin_amdgcn_global_load_lds((const unsigned*)((const char*)(gbase) + (voff)[_i]),                  \
                                             (LAS unsigned*)(lds + (bufoff) + ldsw + _i * 8192), 16, 0, 0);        \
    } while (0)
#define LDA_(dst, b, h)                                                                                             \
    do {                                                                                                           \
        _Pragma("unroll") for (int m = 0; m < 4; ++m) _Pragma("unroll") for (int k = 0; k < 2; ++k)                \
            dst[m][k] = *(const LAS bf16x8*)(lds + SA(b, h) + aoff + m * 2048 + k * 1024);                         \
    } while (0)
#define LDB_(dst, b, h)                                                                                             \
    do {                                                                                                           \
        _Pragma("unroll") for (int n = 0; n < 2; ++n) _Pragma("unroll") for (int k = 0; k < 2; ++k)                \
            dst[n][k] = *(const LAS bf16x8*)(lds + SB(b, h) + boff + n * 2048 + k * 1024);                         \
    } while (0)
#define MMA(ai, bj, At_, Bt_)                                                                                       \
    do {                                                                                                           \
        __builtin_amdgcn_s_setprio(1);                                                                             \
        _Pragma("unroll") for (int m = 0; m < 4; ++m) _Pragma("unroll") for (int n = 0; n < 2; ++n)                \
            _Pragma("unroll") for (int k = 0; k < 2; ++k)                                                          \
                acc[ai][bj][m][n] = __builtin_amdgcn_mfma_f32_16x16x32_bf16(Bt_[n][k], At_[m][k], acc[ai][bj][m][n], 0, 0, 0); \
        __builtin_amdgcn_s_setprio(0);                                                                             \
    } while (0)
#define WAIT_V(n) asm volatile("s_waitcnt vmcnt(" #n ")" ::: "memory")
#define WAIT_L(n) asm volatile("s_waitcnt lgkmcnt(" #n ")" ::: "memory")
#define BAR __builtin_amdgcn_s_barrier()
#define SCHED __builtin_amdgcn_sched_barrier(0)

    f32x4 acc[2][2][4][2];
#pragma unroll
    for (int a = 0; a < 2; ++a)
#pragma unroll
        for (int b = 0; b < 2; ++b)
#pragma unroll
            for (int m = 0; m < 4; ++m)
#pragma unroll
                for (int n = 0; n < 2; ++n) acc[a][b][m][n] = (f32x4){0.f, 0.f, 0.f, 0.f};
    bf16x8 At[4][2], B0[2][2], B1[2][2];
    constexpr int nt = K / 64;
    STAGE(SB(0, 0), cB + BKOFF(0), voffB); STAGE(SA(0, 0), cA + AKOFF(0), voffA);
    STAGE(SB(0, 1), cB + hstepB + BKOFF(0), voffB); STAGE(SA(0, 1), cA + hstepA + AKOFF(0), voffA);
    if (wr == 1) BAR;
    WAIT_V(4); BAR;
    STAGE(SB(1, 0), cB + BKOFF(1), voffB); STAGE(SA(1, 0), cA + AKOFF(1), voffA); STAGE(SB(1, 1), cB + hstepB + BKOFF(1), voffB);
    WAIT_V(6); BAR;
    for (int t = 0; t < nt - 2; t += 2) {
        LDB_(B0, 0, 0); SCHED; LDA_(At, 0, 0); STAGE(SA(1, 1), cA + hstepA + AKOFF(t + 1), voffA);
        WAIT_L(8); BAR; WAIT_L(0); MMA(0, 0, At, B0); BAR; SCHED;
        LDB_(B1, 0, 1); STAGE(SB(0, 0), cB + BKOFF(t + 2), voffB);
        BAR; WAIT_L(0); MMA(0, 1, At, B1); BAR;
        LDA_(At, 0, 1); STAGE(SA(0, 0), cA + AKOFF(t + 2), voffA);
        BAR; WAIT_L(0); MMA(1, 0, At, B0); BAR; SCHED;
        STAGE(SB(0, 1), cB + hstepB + BKOFF(t + 2), voffB);
        WAIT_V(6); BAR; MMA(1, 1, At, B1); BAR;
        LDB_(B0, 1, 0); SCHED; LDA_(At, 1, 0); STAGE(SA(0, 1), cA + hstepA + AKOFF(t + 2), voffA);
        WAIT_L(8); BAR; WAIT_L(0); MMA(0, 0, At, B0); BAR; SCHED;
        LDB_(B1, 1, 1); STAGE(SB(1, 0), cB + BKOFF(t + 3), voffB);
        BAR; WAIT_L(0); MMA(0, 1, At, B1); BAR;
        LDA_(At, 1, 1); STAGE(SA(1, 0), cA + AKOFF(t + 3), voffA);
        BAR; WAIT_L(0); MMA(1, 0, At, B0); BAR; SCHED;
        STAGE(SB(1, 1), cB + hstepB + BKOFF(t + 3), voffB);
        WAIT_V(6); BAR; MMA(1, 1, At, B1); BAR;
    }
    {
        LDB_(B0, 0, 0); LDA_(At, 0, 0); STAGE(SA(1, 1), cA + hstepA + AKOFF(nt - 1), voffA);
        BAR; WAIT_L(0); MMA(0, 0, At, B0); BAR;
        LDB_(B1, 0, 1); BAR; WAIT_L(0); MMA(0, 1, At, B1); BAR;
        LDA_(At, 0, 1); WAIT_V(4); BAR; WAIT_L(0); MMA(1, 0, At, B0); MMA(1, 1, At, B1); BAR;
    }
    {
        LDB_(B0, 1, 0); LDA_(At, 1, 0); WAIT_V(2); BAR; WAIT_L(0); MMA(0, 0, At, B0); BAR;
        LDB_(B1, 1, 1); WAIT_V(0); BAR; WAIT_L(0); MMA(0, 1, At, B1); BAR;
        LDA_(At, 1, 1); BAR; WAIT_L(0); MMA(1, 0, At, B0); MMA(1, 1, At, B1); BAR;
    }
    if (wr == 0) BAR;
    if (GID == 1) {
        if (bcol < 6656) {
            bf16_t* dst0 = (bf16_t*)(p->ws + OFF_PROJ) + (size_t)(brow + wr * 64 + fr) * LDP + bcol + wc * 32 + fq * 4;
#pragma unroll
            for (int ai = 0; ai < 2; ++ai)
#pragma unroll
                for (int m = 0; m < 4; ++m)
#pragma unroll
                    for (int bj = 0; bj < 2; ++bj)
#pragma unroll
                        for (int n = 0; n < 2; ++n)
                            *(u32x2*)(dst0 + (size_t)(ai * HALF + m * 16) * LDP + bj * HALF + n * 16) = pack4(acc[ai][bj][m][n]);
            const int hcb = (bcol >= 3584) ? (bcol - 3584 + 1536) : ((bcol >= 1024 && bcol < 2560) ? (bcol - 1024) : -1);
            if (hcb >= 0 && fr >= 13) {
#pragma unroll
                for (int ai = 0; ai < 2; ++ai) {
                    const int row = brow + ai * HALF + wr * 64 + 48 + fr;
                    bf16_t* hd = (bf16_t*)(p->ws + OFF_HALO) + ((size_t)(row >> 6) * 3 + (fr - 13)) * 4608 + hcb + wc * 32 + fq * 4;
#pragma unroll
                    for (int bj = 0; bj < 2; ++bj)
#pragma unroll
                        for (int n = 0; n < 2; ++n) *(u32x2*)(hd + bj * HALF + n * 16) = pack4(acc[ai][bj][3][n]);
                }
            }
        } else if (wc == 0) {
            float* sd = (float*)(p->ws + OFF_SMALL) + (size_t)(brow + wr * 64 + fr) * 32 + fq * 4;
#pragma unroll
            for (int ai = 0; ai < 2; ++ai)
#pragma unroll
                for (int m = 0; m < 4; ++m)
#pragma unroll
                    for (int n = 0; n < 2; ++n) *(f32x4*)(sd + (size_t)(ai * HALF + m * 16) * 32 + n * 16) = acc[ai][0][m][n];
        }
    } else {
#pragma unroll
        for (int ai = 0; ai < 2; ++ai)
#pragma unroll
            for (int m = 0; m < 4; ++m) {
                const int row = brow + ai * HALF + wr * 64 + m * 16 + fr;
#pragma unroll
                for (int bj = 0; bj < 2; ++bj)
#pragma unroll
                    for (int n = 0; n < 2; ++n) {
                        const int col = bcol + bj * HALF + wc * 32 + fq * 8 + n * 4;
                        const f32x4 xv = *(const f32x4*)(p->x + (size_t)row * DM + col);
                        *(f32x4*)(p->out + (size_t)row * DM + col) = xv + acc[ai][bj][m][n];
                    }
            }
    }
#undef SA
#undef SB
#undef STAGE
#undef LDA_
#undef LDB_
#undef MMA
#undef AKOFF
#undef BKOFF
}


template <int GID>
__device__ __forceinline__ bool gemm_unit(int i, int& pm, int& pn) {
    constexpr int nM = 64, nN = (GID == 1) ? 27 : 4, nwg = nM * nN;
    const long L = (long)i * gridDim.x + blockIdx.x;
    if (L >= nwg) return false;
    int wgid = (int)L;
    {
        const int q = nwg / 8, r = nwg % 8, xcd = wgid % 8, off = wgid / 8;
        wgid = (xcd < r ? xcd * (q + 1) : r * (q + 1) + (xcd - r) * q) + off;
    }
    const int nig = 8 * nN, gid = wgid / nig, fm = gid * 8, gsz = (nM - fm) < 8 ? (nM - fm) : 8;
    pm = fm + ((wgid % nig) % gsz);
    pn = (wgid % nig) / gsz;
    return true;
}

template <int GID>
__device__ __forceinline__ void phase_gemm(PP p, unsigned& bk) {
    constexpr int K = (GID == 1) ? 1024 : 2048;
    constexpr int LDA = (GID == 1) ? 1024 : LDP;
    constexpr int HALF = 128;
    constexpr int HTB = 128 * 64 * 2;
    constexpr int nt = K / 64;
    int pm, pn;
    if (!gemm_unit<GID>(0, pm, pn)) {
        if (GID == 2) fast_grid_barrier((unsigned*)(p->ws + OFF_BAR), bk);
        return;
    }
    LAS unsigned char* lds = (LAS unsigned char*)dsm;
    int tid = threadIdx.x;
    asm volatile("" : "+v"(tid));
    const int wid = __builtin_amdgcn_readfirstlane(tid >> 6), lane = tid & 63, wr = wid >> 2, wc = wid & 3, fr = lane & 15, fq = lane >> 4;
    unsigned voffA[2], voffB[2];
#pragma unroll
    for (int i = 0; i < 2; ++i) {
        int R, C; stage_rc(tid * 16 + i * 8192, R, C);
        const int Rb = (R & ~31) + perm32(R & 31);
        voffA[i] = (unsigned)(R * LDA + C) * 2u; voffB[i] = (unsigned)(Rb * K + C) * 2u;
    }
    const char* Abase = (GID == 1) ? (const char*)p->out : (const char*)(p->ws + OFF_PROJ);
    const char* Bbase = (const char*)(p->ws + (GID == 1 ? OFF_WIN : OFF_WOUT));
    constexpr size_t hstepA = (size_t)HALF * LDA * 2, hstepB = (size_t)HALF * K * 2;
    constexpr size_t tstepA = 2 * hstepA, tstepB = 2 * hstepB;
    const unsigned ldsw = (unsigned)wid * 1024u;
    const int aoff = lds_byte(wr * 64 + fr, fq * 8), boff = lds_byte(wc * 32 + fr, fq * 8);
#define AKOFF(kt) ((GID == 1) ? (size_t)(kt) * 128 : ((kt) < 16 ? (size_t)(1024 + (kt) * 64) * 2 : (size_t)(5632 + ((kt) - 16) * 64) * 2))
#define BKOFF(kt) ((size_t)(kt) * 128)
#define SA(b, h) (((b) * 2 + (h)) * HTB)
#define SB(b, h) ((4 + (b) * 2 + (h)) * HTB)
#define STAGE(bufoff, gbase, voff)                                                                                  \
    do {                                                                                                           \
        _Pragma("unroll") for (int _i = 0; _i < 2; ++_i)                                                           \
            __builtin_amdgcn_global_load_lds((const unsigned*)((const char*)(gbase) + (voff)[_i]),                  \
                                             (LAS unsigned*)(lds + (bufoff) + ldsw + _i * 8192), 16, 0, 0);        \
    } while (0)
#define LDA_(dst, b, h)                                                                                             \
    do {                                                                                                           \
        _Pragma("unroll") for (int m = 0; m < 4; ++m) _Pragma("unroll") for (int k = 0; k < 2; ++k)                \
            dst[m][k] = *(const LAS bf16x8*)(lds + SA(b, h) + aoff + m * 2048 + k * 1024);                         \
    } while (0)
#define LDB_(dst, b, h)                                                                                             \
    do {                                                                                                           \
        _Pragma("unroll") for (int n = 0; n < 2; ++n) _Pragma("unroll") for (int k = 0; k < 2; ++k)                \
            dst[n][k] = *(const LAS bf16x8*)(lds + SB(b, h) + boff + n * 2048 + k * 1024);                         \
    } while (0)
#define MMA(ai, bj, At_, Bt_)                                                                                       \
    do {                                                                                                           \
        __builtin_amdgcn_s_setprio(1);                                                                             \
        _Pragma("unroll") for (int m = 0; m < 4; ++m) _Pragma("unroll") for (int n = 0; n < 2; ++n)                \
            _Pragma("unroll") for (int k = 0; k < 2; ++k)                                                          \
                acc[ai][bj][m][n] = __builtin_amdgcn_mfma_f32_16x16x32_bf16(Bt_[n][k], At_[m][k], acc[ai][bj][m][n], 0, 0, 0); \
        __builtin_amdgcn_s_setprio(0);                                                                             \
    } while (0)
#define WAIT_V(n) asm volatile("s_waitcnt vmcnt(" #n ")" ::: "memory")
#define WAIT_L(n) asm volatile("s_waitcnt lgkmcnt(" #n ")" ::: "memory")
#define BAR __builtin_amdgcn_s_barrier()
#define SCHED __builtin_amdgcn_sched_barrier(0)

    f32x4 acc[2][2][4][2];
#pragma unroll
    for (int a = 0; a < 2; ++a)
#pragma unroll
        for (int b = 0; b < 2; ++b)
#pragma unroll
            for (int m = 0; m < 4; ++m)
#pragma unroll
                for (int n = 0; n < 2; ++n) acc[a][b][m][n] = (f32x4){0.f, 0.f, 0.f, 0.f};
    bf16x8 At[4][2], B0[2][2], B1[2][2];
    const char* cA = Abase + (size_t)pm * tstepA;
    const char* cB = Bbase + (size_t)pn * tstepB;
    STAGE(SB(0, 0), cB + BKOFF(0), voffB); STAGE(SA(0, 0), cA + AKOFF(0), voffA);
    STAGE(SB(0, 1), cB + hstepB + BKOFF(0), voffB); STAGE(SA(0, 1), cA + hstepA + AKOFF(0), voffA);
    if (wr == 1) BAR;
    WAIT_V(4); BAR;
    STAGE(SB(1, 0), cB + BKOFF(1), voffB); STAGE(SA(1, 0), cA + AKOFF(1), voffA); STAGE(SB(1, 1), cB + hstepB + BKOFF(1), voffB);
    WAIT_V(6); BAR;
    for (int ui = 0;; ++ui) {
        int npm, npn;
        const bool has_next = gemm_unit<GID>(ui + 1, npm, npn);
        const char* nA = has_next ? Abase + (size_t)npm * tstepA : cA;
        const char* nB = has_next ? Bbase + (size_t)npn * tstepB : cB;
        for (int t = 0; t < nt; t += 2) {
            const bool last = (t == nt - 2);
            const char* a1 = cA + AKOFF(t + 1);
            const char* a2 = last ? nA + AKOFF(0) : cA + AKOFF(t + 2);
            const char* b2 = last ? nB + BKOFF(0) : cB + BKOFF(t + 2);
            const char* a3 = last ? nA + AKOFF(1) : cA + AKOFF(t + 3);
            const char* b3 = last ? nB + BKOFF(1) : cB + BKOFF(t + 3);
            LDB_(B0, 0, 0); SCHED; LDA_(At, 0, 0); STAGE(SA(1, 1), a1 + hstepA, voffA);
            WAIT_L(8); BAR; WAIT_L(0); MMA(0, 0, At, B0); BAR; SCHED;
            LDB_(B1, 0, 1); STAGE(SB(0, 0), b2, voffB);
            BAR; WAIT_L(0); MMA(0, 1, At, B1); BAR;
            LDA_(At, 0, 1); STAGE(SA(0, 0), a2, voffA);
            BAR; WAIT_L(0); MMA(1, 0, At, B0); BAR; SCHED;
            STAGE(SB(0, 1), b2 + hstepB, voffB);
            WAIT_V(6); BAR; MMA(1, 1, At, B1); BAR;
            LDB_(B0, 1, 0); SCHED; LDA_(At, 1, 0); STAGE(SA(0, 1), a2 + hstepA, voffA);
            WAIT_L(8); BAR; WAIT_L(0); MMA(0, 0, At, B0); BAR; SCHED;
            LDB_(B1, 1, 1); STAGE(SB(1, 0), b3, voffB);
            BAR; WAIT_L(0); MMA(0, 1, At, B1); BAR;
            LDA_(At, 1, 1); STAGE(SA(1, 0), a3, voffA);
            BAR; WAIT_L(0); MMA(1, 0, At, B0); BAR; SCHED;
            STAGE(SB(1, 1), b3 + hstepB, voffB);
            WAIT_V(6); BAR; MMA(1, 1, At, B1); BAR;
        }
        const int brow = pm * 256, bcol = pn * 256;
        if (GID == 1) {
            if (bcol < 6656) {
                bf16_t* dst0 = (bf16_t*)(p->ws + OFF_PROJ) + (size_t)(brow + wr * 64 + fr) * LDP + bcol + wc * 32 + fq * 8;
#pragma unroll
                for (int ai = 0; ai < 2; ++ai)
#pragma unroll
                    for (int m = 0; m < 4; ++m)
#pragma unroll
                        for (int bj = 0; bj < 2; ++bj) {
                            const u32x2 lo = pack4(acc[ai][bj][m][0]), hi = pack4(acc[ai][bj][m][1]);
                            *(u32x4*)(dst0 + (size_t)(ai * HALF + m * 16) * LDP + bj * HALF) = (u32x4){lo[0], lo[1], hi[0], hi[1]};
                        }
                const int hcb = (bcol >= 3584) ? (bcol - 3584 + 1536) : ((bcol >= 1024 && bcol < 2560) ? (bcol - 1024) : -1);
                if (hcb >= 0 && fr >= 13) {
#pragma unroll
                    for (int ai = 0; ai < 2; ++ai) {
                        const int row = brow + ai * HALF + wr * 64 + 48 + fr;
                        bf16_t* hd = (bf16_t*)(p->ws + OFF_HALO) + ((size_t)(row >> 6) * 3 + (fr - 13)) * 4608 + hcb + wc * 32 + fq * 8;
#pragma unroll
                        for (int bj = 0; bj < 2; ++bj) {
                            const u32x2 lo = pack4(acc[ai][bj][3][0]), hi = pack4(acc[ai][bj][3][1]);
                            *(u32x4*)(hd + bj * HALF) = (u32x4){lo[0], lo[1], hi[0], hi[1]};
                        }
                    }
                }
            } else if (wc == 0) {
                float* sd = (float*)(p->ws + OFF_SMALL) + (size_t)(brow + wr * 64 + fr) * 32 + fq * 8;
#pragma unroll
                for (int ai = 0; ai < 2; ++ai)
#pragma unroll
                    for (int m = 0; m < 4; ++m)
#pragma unroll
                        for (int n = 0; n < 2; ++n) *(f32x4*)(sd + (size_t)(ai * HALF + m * 16) * 32 + n * 4) = acc[ai][0][m][n];
            }
        }
        if (!has_next) break;
#pragma unroll
        for (int a = 0; a < 2; ++a)
#pragma unroll
            for (int b = 0; b < 2; ++b)
#pragma unroll
                for (int m = 0; m < 4; ++m)
#pragma unroll
                    for (int n = 0; n < 2; ++n) acc[a][b][m][n] = (f32x4){0.f, 0.f, 0.f, 0.f};
        pm = npm; pn = npn; cA = nA; cB = nB;
    }
    WAIT_V(0);
    if (wr == 0) BAR;
    BAR;
    if (GID == 2) {
        const int brow = pm * 256, bcol = pn * 256;
        LAS float* red = (LAS float*)dsm;
        float* rowss = (float*)(p->ws + OFF_ROWSS);
#pragma unroll
        for (int ai = 0; ai < 2; ++ai)
#pragma unroll
            for (int m = 0; m < 4; ++m) {
                const int rl = ai * HALF + wr * 64 + m * 16 + fr;
                float ss = 0.f;
#pragma unroll
                for (int bj = 0; bj < 2; ++bj)
#pragma unroll
                    for (int n = 0; n < 2; ++n) {
                        const int col = bcol + bj * HALF + wc * 32 + fq * 8 + n * 4;
                        const f32x4 xv = *(const f32x4*)(p->x + (size_t)(brow + rl) * DM + col);
                        f32x4 hv = xv + acc[ai][bj][m][n];
                        acc[ai][bj][m][n] = hv;
                        ss += hv[0] * hv[0] + hv[1] * hv[1] + hv[2] * hv[2] + hv[3] * hv[3];
                    }
                ss += __shfl_xor(ss, 16, 64);
                ss += __shfl_xor(ss, 32, 64);
                if (fq == 0) red[rl * 4 + wc] = ss;
            }
        __syncthreads();
        if (tid < 256) {
            const f32x4 r4 = *(const LAS f32x4*)(red + tid * 4);
            rowss[(size_t)pn * MTOK + brow + tid] = (r4[0] + r4[1]) + (r4[2] + r4[3]);
        }
        if (gridDim.x == 256) {
            asm volatile("s_waitcnt vmcnt(0)" ::: "memory");
            __syncthreads();
            if (threadIdx.x == 0) {
                unsigned* pc = (unsigned*)(p->ws + OFF_BAR) + 64 * (19 + pm);
                __builtin_amdgcn_fence(__ATOMIC_RELEASE, "agent");
                asm volatile("s_waitcnt vmcnt(0)" ::: "memory");
                gb_add(pc);
                while (gb_ld(pc) < 4u) __builtin_amdgcn_s_sleep(1);
                __builtin_amdgcn_fence(__ATOMIC_ACQUIRE, "agent");
                asm volatile("s_waitcnt vmcnt(0)" ::: "memory");
            }
            __syncthreads();
        } else {
            fast_grid_barrier((unsigned*)(p->ws + OFF_BAR), bk);
        }
#pragma unroll
        for (int ai = 0; ai < 2; ++ai)
#pragma unroll
            for (int m = 0; m < 4; ++m) {
                const int row = brow + ai * HALF + wr * 64 + m * 16 + fr;
                const float tot = (rowss[row] + rowss[MTOK + row]) + (rowss[2 * MTOK + row] + rowss[3 * MTOK + row]);
                const float rs = rsqrtf(tot * (1.f / DM) + 1e-6f);
#pragma unroll
                for (int bj = 0; bj < 2; ++bj)
#pragma unroll
                    for (int n = 0; n < 2; ++n) {
                        const int col = bcol + bj * HALF + wc * 32 + fq * 8 + n * 4;
                        const f32x4 wv = *(const f32x4*)(p->final_norm_w + col);
                        *(f32x4*)(p->out + (size_t)row * DM + col) = acc[ai][bj][m][n] * rs * wv;
                    }
            }
    }
#undef SA
#undef SB
#undef STAGE
#undef LDA_
#undef LDB_
#undef MMA
#undef AKOFF
#undef BKOFF
}

__device__ __forceinline__ void conv8x8(const bf16_t* __restrict__ projcol, const bf16_t* __restrict__ halocol, bool first, int l0,
                                        const float* __restrict__ cw, int cwld, const float* __restrict__ bias, float (&val)[8][8]) {
    float w[4][8];
#pragma unroll
    for (int k = 0; k < 4; k++) {
        const float4 a = *(const float4*)(cw + (size_t)k * cwld), b = *(const float4*)(cw + (size_t)k * cwld + 4);
        w[k][0] = a.x; w[k][1] = a.y; w[k][2] = a.z; w[k][3] = a.w; w[k][4] = b.x; w[k][5] = b.y; w[k][6] = b.z; w[k][7] = b.w;
    }
    float bb[8];
#pragma unroll
    for (int i = 0; i < 8; i++) bb[i] = 0.f;
    if (bias) {
        const float4 a = *(const float4*)(bias), b = *(const float4*)(bias + 4);
        bb[0] = a.x; bb[1] = a.y; bb[2] = a.z; bb[3] = a.w; bb[4] = b.x; bb[5] = b.y; bb[6] = b.z; bb[7] = b.w;
    }
    float x0[8], x1[8], x2[8];
#pragma unroll
    for (int i = 0; i < 8; i++) { x0[i] = 0.f; x1[i] = 0.f; x2[i] = 0.f; }
#pragma unroll
    for (int r = -3; r < 8; r++) {
        const int l = l0 + r;
        bf16x8 raw = {0, 0, 0, 0, 0, 0, 0, 0};
        if (l >= 0) raw = *(const bf16x8*)(projcol + (size_t)l * LDP);
        else if (!first) raw = *(const bf16x8*)(halocol + (size_t)(l + 3) * 4608);
        float cur[8];
        unpack8(raw, cur);
        if (r >= 0) {
#pragma unroll
            for (int i = 0; i < 8; i++) {
                const float a = bb[i] + w[0][i] * x0[i] + w[1][i] * x1[i] + w[2][i] * x2[i] + w[3][i] * cur[i];
                val[r][i] = silu_f(a);
            }
        }
#pragma unroll
        for (int i = 0; i < 8; i++) { x0[i] = x1[i]; x1[i] = x2[i]; x2[i] = cur[i]; }
    }
}

template <int VAR>
__device__ __forceinline__ void gdn_item(PP p, const int ch, const int h) {
    LAS char* lb = (LAS char*)dsm;
    asm volatile("" : "+v"(lb));
    LAS bf16_t* QN = (LAS bf16_t*)lb;
    LAS bf16_t* KN = (LAS bf16_t*)(lb + 17408);
    LAS float* VF = (LAS float*)(lb + 34816);
    LAS float* AM = (LAS float*)(lb + 67584);
    LAS float* GC = (LAS float*)(lb + 84992);
    LAS float* BETA = GC + 64;
    LAS float* EG = GC + 128;
    LAS float* TI = (LAS float*)(lb + 85760);
    int tid = threadIdx.x;
    asm volatile("" : "+v"(tid));
    const int lane = tid & 63, wid = tid >> 6, fr = lane & 15, fq = lane >> 4;
    bf16_t* PROJ = (bf16_t*)(p->ws + OFF_PROJ);
    float* SMALL = (float*)(p->ws + OFF_SMALL);
    const bf16_t* HALO = (const bf16_t*)(p->ws + OFF_HALO);
    bf16_t* QD = (bf16_t*)p->out;
    bf16_t* ATTN = (bf16_t*)((char*)p->out + OUT_ATTN_OFF);
    const size_t row0 = (size_t)ch * 64;
    const int item = ch * 8 + h;
    const bool first = (ch & 127) == 0;
    {
        const int g16 = tid >> 4, c8 = tid & 15, blk = g16 >> 3, tr = g16 & 7, l0 = tr * 8;
        if (blk < 3) {
            const int cc = blk * 1024 + h * 128 + c8 * 8;
            float val[8][8];
            conv8x8(PROJ + row0 * LDP + QKV0 + cc, HALO + (size_t)(ch - 1) * 3 * 4608 + 1536 + cc, first, l0,
                    p->gdn_conv_w + cc, 3072, nullptr, val);
            if (blk < 2) {
                LAS bf16_t* ldst = blk == 0 ? QN : KN;
                const float extra = blk == 0 ? 0.08838834764831845f : 1.f;
#pragma unroll
                for (int t = 0; t < 8; t++) {
                    float ss = 0.f;
#pragma unroll
                    for (int i = 0; i < 8; i++) ss += val[t][i] * val[t][i];
                    ss += __shfl_xor(ss, 1, 64); ss += __shfl_xor(ss, 2, 64); ss += __shfl_xor(ss, 4, 64); ss += __shfl_xor(ss, 8, 64);
                    const float sc = rsqrtf(ss + 1e-6f) * extra;
                    float f[8];
#pragma unroll
                    for (int i = 0; i < 8; i++) f[i] = val[t][i] * sc;
                    *(LAS u32x4*)(ldst + (l0 + t) * 136 + c8 * 8) = pack8(f);
                }
            } else {
#pragma unroll
                for (int t = 0; t < 8; t++) {
                    *(LAS f32x4*)(VF + (l0 + t) * 128 + c8 * 8) = (f32x4){val[t][0], val[t][1], val[t][2], val[t][3]};
                    *(LAS f32x4*)(VF + (l0 + t) * 128 + c8 * 8 + 4) = (f32x4){val[t][4], val[t][5], val[t][6], val[t][7]};
                }
            }
        } else if (wid == 7) {
            float* sa = SMALL + (row0 + lane) * 32 + 16 + h;
            const float a_raw = sa[0], b_raw = sa[8];
            const float beta = 1.f / (1.f + expf(-b_raw));
            const float g = -expf(p->gdn_a_log[h]) * softplus_f(a_raw + p->gdn_dt_bias[h]);
            const float gc = wave_incl_scan(g, lane);
            const float eg = expf(gc);
            GC[lane] = gc; BETA[lane] = beta; EG[lane] = eg;
            sa[0] = eg;
        }
    }
    __syncthreads();
    {
        const int i = wid & 3, jj = wid >> 2;
#pragma unroll
        for (int jt = 0; jt < 2; jt++) {
            const int j = jj * 2 + jt;
            f32x4 aK = {0.f, 0.f, 0.f, 0.f}, aQ = {0.f, 0.f, 0.f, 0.f};
            if (j <= i) {
#pragma unroll
                for (int ks = 0; ks < 4; ks++) {
                    const bf16x8 kj = *(const LAS bf16x8*)(KN + (16 * j + fr) * 136 + 32 * ks + 8 * fq);
                    const bf16x8 ki = *(const LAS bf16x8*)(KN + (16 * i + fr) * 136 + 32 * ks + 8 * fq);
                    const bf16x8 qi = *(const LAS bf16x8*)(QN + (16 * i + fr) * 136 + 32 * ks + 8 * fq);
                    aK = mfma16(kj, ki, aK);
                    aQ = mfma16(kj, qi, aQ);
                }
            }
            const int l = 16 * i + fr;
            const float gl_ = GC[l], bl = BETA[l];
            f32x4 am, at;
#pragma unroll
            for (int r = 0; r < 4; r++) {
                const int s = 16 * j + 4 * fq + r;
                const float dec = (l >= s) ? __expf(gl_ - GC[s]) : 0.f;
                am[r] = (l > s) ? bl * aK[r] * dec : 0.f;
                at[r] = (l >= s) ? aQ[r] * dec : 0.f;
            }
            *(LAS f32x4*)(AM + l * 68 + 16 * j + 4 * fq) = am;
            *(u32x2*)(ATTN + ((size_t)item * 64 + l) * 64 + 16 * j + 4 * fq) = pack4(at);
        }
    }
    __syncthreads();
    if (VAR == 13) { __syncthreads(); return; }
    if (wid == 0) {
        const int blk = lane >> 4, j = lane & 15;
        float x[16];
#pragma unroll
        for (int r = 0; r < 16; r++) {
            float v = (r == j) ? 1.f : 0.f;
#pragma unroll
            for (int m4 = 0; m4 * 4 < r; m4++) {
                const f32x4 a = *(const LAS f32x4*)(AM + (16 * blk + r) * 68 + 16 * blk + m4 * 4);
#pragma unroll
                for (int q = 0; q < 4; q++)
                    if (m4 * 4 + q < r) v -= a[q] * x[m4 * 4 + q];
            }
            x[r] = v;
            TI[blk * 256 + r * 16 + j] = v;
        }
    } else if (wid >= 4) {
        const int t2 = tid - 256;
        const float gL = GC[63];
#pragma unroll
        for (int it = 0; it < 4; it++) {
            const int o = t2 + 256 * it, l = o >> 4, d8 = (o & 15) * 8;
            const bf16x8 q = *(const LAS bf16x8*)(QN + l * 136 + d8);
            float f[8];
            unpack8(q, f);
            const float e = EG[l];
#pragma unroll
            for (int i = 0; i < 8; i++) f[i] *= e;
            *(u32x4*)(QD + ((size_t)item * 64 + l) * 128 + d8) = pack8(f);
        }
#pragma unroll
        for (int it = 0; it < 4; it++) {
            const int o = t2 + 256 * it, d = o & 127, l8 = (o >> 7) * 8;
            float f[8];
#pragma unroll
            for (int t = 0; t < 8; t++) f[t] = bf2f(KN[(l8 + t) * 136 + d]) * __expf(gL - GC[l8 + t]);
            *(u32x4*)(PROJ + (row0 + (d >> 1)) * LDP + QKV0 + 1024 + h * 128 + (d & 1) * 64 + l8) = pack8(f);
        }
    }
    __syncthreads();
    {
        const bool isv = wid < 4;
#pragma unroll
        for (int cc = 0; cc < 2; cc++) {
            const int n = 16 * (2 * wid + cc) + fr;
            f32x4 X[4];
#pragma unroll
            for (int i = 0; i < 4; i++) {
                f32x4 acc;
#pragma unroll
                for (int r = 0; r < 4; r++) {
                    const int l = 16 * i + 4 * fq + r;
                    acc[r] = isv ? VF[l * 128 + n] * BETA[l] : bf2f(KN[l * 136 + (n & 127)]) * (BETA[l] * EG[l]);
                }
#pragma unroll
                for (int j = 0; j < i; j++) {
                    const f32x4 av = *(const LAS f32x4*)(AM + (16 * i + fr) * 68 + 16 * j + 4 * fq);
#pragma unroll
                    for (int q = 0; q < 4; q++) acc = __builtin_amdgcn_mfma_f32_16x16x4f32(-av[q], X[j][q], acc, 0, 0, 0);
                }
                const f32x4 tv = *(const LAS f32x4*)(TI + i * 256 + fr * 16 + 4 * fq);
                f32x4 xi = {0.f, 0.f, 0.f, 0.f};
#pragma unroll
                for (int q = 0; q < 4; q++) xi = __builtin_amdgcn_mfma_f32_16x16x4f32(tv[q], acc[q], xi, 0, 0, 0);
                X[i] = xi;
            }
            if (isv) {
                bf16_t* dst = PROJ + (row0 + (n >> 1)) * LDP + QKV0 + 2048 + h * 128 + (n & 1) * 64 + 4 * fq;
#pragma unroll
                for (int i = 0; i < 4; i++) *(u32x2*)(dst + 16 * i) = pack4(X[i]);
            } else {
                bf16_t* dst = PROJ + (row0 + 4 * fq) * LDP + QKV0 + h * 128 + (n & 127);
#pragma unroll
                for (int i = 0; i < 4; i++)
#pragma unroll
                    for (int r = 0; r < 4; r++) dst[(size_t)(16 * i + r) * LDP] = f2bf(X[i][r]);
            }
        }
    }
    __syncthreads();
}

__device__ __forceinline__ int xdt_off(int row, int l) { return row * 72 + ((((l >> 3) ^ ((row >> 3) & 7)) << 3) | (l & 7)); }

template <int VAR>
__device__ __forceinline__ void ssd_item(PP p, const int ch, const int g) {
    LAS char* lb = (LAS char*)dsm;
    asm volatile("" : "+v"(lb));
    LAS float* DT = (LAS float*)lb;
    LAS float* LC = (LAS float*)(lb + 2048);
    LAS bf16_t* XDT = (LAS bf16_t*)(lb + 4096);
    LAS bf16_t* BN = (LAS bf16_t*)(lb + 77824);
    LAS bf16_t* CN = (LAS bf16_t*)(lb + 95232);
    LAS float* CB = (LAS float*)(lb + 112640);
    LAS float* ES = (LAS float*)(lb + 130048);
    int tid = threadIdx.x;
    asm volatile("" : "+v"(tid));
    const int lane = tid & 63, wid = tid >> 6, fr = lane & 15, fq = lane >> 4;
    bf16_t* PROJ = (bf16_t*)(p->ws + OFF_PROJ);
    float* SMALL = (float*)(p->ws + OFF_SMALL);
    const bf16_t* HALO = (const bf16_t*)(p->ws + OFF_HALO);
    bf16_t* YPART = (bf16_t*)(p->ws + OFF_YPART);
    const size_t row0 = (size_t)ch * 64;
    const bool first = (ch & 127) == 0;
    {
        const int hh = 8 * g + wid;
        float* sp = SMALL + (row0 + lane) * 32 + hh;
        const float dt = softplus_f(sp[0] + p->ssd_dt_bias[hh]);
        const float la = -expf(p->ssd_a_log[hh]) * dt;
        const float lc = wave_incl_scan(la, lane);
        DT[wid * 64 + lane] = dt;
        LC[wid * 64 + lane] = lc;
        ES[wid * 64 + lane] = __expf(__shfl(lc, 63, 64) - lc);
        sp[0] = expf(lc);
    }
    __syncthreads();
    for (int task = tid; task < 768; task += 512) {
        const int co = task % 96, tr = task / 96, l0 = tr * 8;
        const int xc = (co < 64) ? g * 512 + co * 8 : (co < 80 ? 1024 + g * 128 + (co - 64) * 8 : 1280 + g * 128 + (co - 80) * 8);
        float val[8][8];
        conv8x8(PROJ + row0 * LDP + XBC0 + xc, HALO + (size_t)(ch - 1) * 3 * 4608 + xc, first, l0,
                p->ssd_conv_w + xc, 1536, p->ssd_conv_b + xc, val);
        if (co < 64) {
            const int hl = co >> 3, p0 = (co & 7) * 8;
            float dtv[8];
#pragma unroll
            for (int t = 0; t < 8; t++) dtv[t] = DT[hl * 64 + l0 + t];
#pragma unroll
            for (int i = 0; i < 8; i++) {
                float f[8];
#pragma unroll
                for (int t = 0; t < 8; t++) f[t] = val[t][i] * dtv[t];
                *(LAS u32x4*)(XDT + xdt_off(hl * 64 + p0 + i, l0)) = pack8(f);
            }
        } else {
            LAS bf16_t* ldst = (co < 80) ? BN : CN;
            const int n0 = ((co - 64) & 15) * 8;
#pragma unroll
            for (int t = 0; t < 8; t++) *(LAS u32x4*)(ldst + (l0 + t) * 136 + n0) = pack8(val[t]);
        }
    }
    __syncthreads();
    if (VAR == 17) { __syncthreads(); return; }
#pragma unroll
    for (int it = 0; it < 8; it++) {
        const int idx = tid + 512 * it, hl = idx >> 9, pp = (idx >> 3) & 63, l0 = (idx & 7) * 8;
        const bf16x8 a = *(const LAS bf16x8*)(XDT + xdt_off(hl * 64 + pp, l0));
        float f[8];
        unpack8(a, f);
        const f32x4 e0 = *(const LAS f32x4*)(ES + hl * 64 + l0), e1 = *(const LAS f32x4*)(ES + hl * 64 + l0 + 4);
#pragma unroll
        for (int t = 0; t < 4; t++) { f[t] *= e0[t]; f[4 + t] *= e1[t]; }
        *(u32x4*)(PROJ + (row0 + pp) * LDP + XBC0 + (8 * g + hl) * 64 + l0) = pack8(f);
    }
#pragma unroll
    for (int it = 0; it < 2; it++) {
        const int idx = tid + 512 * it, n = idx & 127, l0 = (idx >> 7) * 8;
        u32x4 o;
#pragma unroll
        for (int t = 0; t < 4; t++)
            o[t] = (unsigned)BN[(l0 + 2 * t) * 136 + n] | ((unsigned)BN[(l0 + 2 * t + 1) * 136 + n] << 16);
        *(u32x4*)(PROJ + (row0 + (n >> 1)) * LDP + XBC0 + 1024 + g * 128 + (n & 1) * 64 + l0) = o;
    }
#pragma unroll
    for (int it = 0; it < 2; it++) {
        const int idx = tid + 512 * it, l = idx >> 4, n8 = (idx & 15) * 8;
        *(u32x4*)(PROJ + (row0 + l) * LDP + XBC0 + 1280 + g * 128 + n8) = *(const LAS u32x4*)(CN + l * 136 + n8);
    }
    {
        const int i = wid & 3, jj = wid >> 2;
#pragma unroll
        for (int jt = 0; jt < 2; jt++) {
            const int j = jj * 2 + jt;
            f32x4 a = {0.f, 0.f, 0.f, 0.f};
#pragma unroll
            for (int ks = 0; ks < 4; ks++) {
                const bf16x8 bs = *(const LAS bf16x8*)(BN + (16 * j + fr) * 136 + 32 * ks + 8 * fq);
                const bf16x8 cl = *(const LAS bf16x8*)(CN + (16 * i + fr) * 136 + 32 * ks + 8 * fq);
                a = mfma16(bs, cl, a);
            }
            *(LAS f32x4*)(CB + (16 * i + fr) * 68 + 16 * j + 4 * fq) = a;
        }
    }
    __syncthreads();
    if (VAR == 18) { __syncthreads(); return; }
    {
        const int hh = 8 * g + wid;
        f32x4 acc[4][4];
#pragma unroll
        for (int a = 0; a < 4; a++)
#pragma unroll
            for (int b = 0; b < 4; b++) acc[a][b] = (f32x4){0.f, 0.f, 0.f, 0.f};
#pragma unroll
        for (int i = 0; i < 4; i++) {
            const int l = 16 * i + fr;
            const float lcl = LC[wid * 64 + l];
#pragma unroll
            for (int ks = 0; ks < 2; ks++) {
                if (32 * ks > 16 * i + 15) continue;
                const int s0 = 32 * ks + 8 * fq;
                const f32x4 cb0 = *(const LAS f32x4*)(CB + l * 68 + s0), cb1 = *(const LAS f32x4*)(CB + l * 68 + s0 + 4);
                const f32x4 ls0 = *(const LAS f32x4*)(LC + wid * 64 + s0), ls1 = *(const LAS f32x4*)(LC + wid * 64 + s0 + 4);
                float mv[8];
#pragma unroll
                for (int t = 0; t < 4; t++) {
                    mv[t] = (s0 + t <= l) ? cb0[t] * __expf(lcl - ls0[t]) : 0.f;
                    mv[4 + t] = (s0 + 4 + t <= l) ? cb1[t] * __expf(lcl - ls1[t]) : 0.f;
                }
                const bf16x8 mf = __builtin_bit_cast(bf16x8, pack8(mv));
#pragma unroll
                for (int pt = 0; pt < 4; pt++) {
                    const bf16x8 a = *(const LAS bf16x8*)(XDT + xdt_off(wid * 64 + 16 * pt + fr, s0));
                    acc[pt][i] = mfma16(a, mf, acc[pt][i]);
                }
            }
        }
        const float dcoef0 = p->ssd_d[hh];
#pragma unroll
        for (int i = 0; i < 4; i++) {
            const int l = 16 * i + fr;
            const float dcoef = dcoef0 / DT[wid * 64 + l];
#pragma unroll
            for (int pt = 0; pt < 4; pt++) {
                f32x4 v = acc[pt][i];
#pragma unroll
                for (int r = 0; r < 4; r++) v[r] += dcoef * bf2f(XDT[xdt_off(wid * 64 + 16 * pt + 4 * fq + r, l)]);
                *(u32x2*)(YPART + (row0 + l) * 1024 + hh * 64 + 16 * pt + 4 * fq) = pack4(v);
            }
        }
    }
    __syncthreads();
}

template <int VAR>
__device__ __forceinline__ void phase_b(PP p) {
    for (int it = blockIdx.x; it < 2560; it += gridDim.x) {
        if (it < 2048) { if (VAR != 14 && VAR != 17 && VAR != 18) gdn_item<VAR>(p, it >> 3, it & 7); }
        else if (VAR == 0 || VAR == 14) ssd_item<0>(p, (it - 2048) >> 1, (it - 2048) & 1);
        else if (VAR == 17 || VAR == 18) ssd_item<VAR>(p, (it - 2048) >> 1, (it - 2048) & 1);
    }
}

struct GdnOps { bf16x8 wA[4], qA[4], aA[2], kA[2][2]; bf16x4 u; float gl; };

template <int DRY>
__device__ __forceinline__ void gdn_scan(PP p, const int bh, const int es) {
    LAS char* lb = (LAS char*)dsm;
    asm volatile("" : "+v"(lb));
    LAS bf16_t* SBuf = (LAS bf16_t*)lb;
    LAS bf16_t* VN = (LAS bf16_t*)(lb + 8704);
    const int tid = tid_opaque(), lane = tid & 63, wid = tid >> 6, fr = lane & 15, fq = lane >> 4;
    bf16_t* PROJ = (bf16_t*)(p->ws + OFF_PROJ);
    const float* SMALL = (const float*)(p->ws + OFF_SMALL);
    const bf16_t* QD = (const bf16_t*)p->out;
    const bf16_t* ATTN = (const bf16_t*)((const char*)p->out + OUT_ATTN_OFF);
    const int b = bh >> 3, h = bh & 7;
    const int i = wid & 3, jc = wid >> 2;
    const int e_loc = 16 * jc + fr, e = es * 32 + e_loc;
    const int dt0 = 2 * i;
    for (int idx = tid; idx < 32 * 136 / 2; idx += NTHR) ((LAS unsigned*)SBuf)[idx] = 0u;
    f32x4 S0 = {0.f, 0.f, 0.f, 0.f}, S1 = {0.f, 0.f, 0.f, 0.f};

    auto load = [&](int c, GdnOps& o) {
        const int ch = b * 128 + c;
        const size_t row0 = (size_t)ch * 64;
        const int item = ch * 8 + h;
        const bf16_t* wrow = PROJ + (row0 + 16 * i + fr) * LDP + QKV0 + h * 128 + 8 * fq;
        const bf16_t* qrow = QD + ((size_t)item * 64 + 16 * i + fr) * 128 + 8 * fq;
        const bf16_t* arow = ATTN + ((size_t)item * 64 + 16 * i + fr) * 64 + 8 * fq;
#pragma unroll
        for (int ks = 0; ks < 4; ks++) { o.wA[ks] = *(const bf16x8*)(wrow + 32 * ks); o.qA[ks] = *(const bf16x8*)(qrow + 32 * ks); }
#pragma unroll
        for (int ks = 0; ks < 2; ks++) o.aA[ks] = *(const bf16x8*)(arow + 32 * ks);
#pragma unroll
        for (int t = 0; t < 2; t++) {
            const int d = 16 * (dt0 + t) + fr;
            const bf16_t* krow = PROJ + (row0 + (d >> 1)) * LDP + QKV0 + 1024 + h * 128 + (d & 1) * 64 + 8 * fq;
#pragma unroll
            for (int ks = 0; ks < 2; ks++) o.kA[t][ks] = *(const bf16x8*)(krow + 32 * ks);
        }
        o.u = *(const bf16x4*)(PROJ + (row0 + (e >> 1)) * LDP + QKV0 + 2048 + h * 128 + (e & 1) * 64 + 16 * i + 4 * fq);
        o.gl = SMALL[(row0 + 63) * 32 + 16 + h];
    };
    float sink = 0.f;
    GdnOps cur, nxt;
    load(0, cur);
    nxt = cur;
    lds_barrier();
    for (int c = 0; c < 128; c++) {
        if (c + 1 < 128) load(c + 1, nxt);
        f32x4 aP = {0.f, 0.f, 0.f, 0.f}, aO = {0.f, 0.f, 0.f, 0.f};
#pragma unroll
        for (int ks = 0; ks < 4; ks++) {
            const bf16x8 bS = *(const LAS bf16x8*)(SBuf + e_loc * 136 + 32 * ks + 8 * fq);
            aP = mfma16(cur.wA[ks], bS, aP);
            aO = mfma16(cur.qA[ks], bS, aO);
        }
        {
            float uf[4];
            unpack4(cur.u, uf);
            f32x4 vn;
#pragma unroll
            for (int r = 0; r < 4; r++) vn[r] = uf[r] - aP[r];
            *(LAS u32x2*)(VN + e_loc * 72 + 16 * i + 4 * fq) = pack4(vn);
        }
        lds_barrier();
        bf16x8 bV[2];
#pragma unroll
        for (int ks = 0; ks < 2; ks++) bV[ks] = *(const LAS bf16x8*)(VN + e_loc * 72 + 32 * ks + 8 * fq);
#pragma unroll
        for (int ks = 0; ks < 2; ks++) aO = mfma16(cur.aA[ks], bV[ks], aO);
        {
            const size_t row0 = (size_t)(b * 128 + c) * 64;
            bf16_t* od = PROJ + (row0 + (e >> 1)) * LDP + QKV0 + 2048 + h * 128 + (e & 1) * 64 + 16 * i + 4 * fq;
            if (DRY) od = (bf16_t*)((char*)p->out + 52428800 + (((size_t)((char*)od - (char*)PROJ)) & 0x7ffff8));
            if (DRY == 2) sink += aO[0] + aO[1] + aO[2] + aO[3]; else *(u32x2*)od = pack4(aO);
        }
        S0 *= cur.gl; S1 *= cur.gl;
#pragma unroll
        for (int ks = 0; ks < 2; ks++) { S0 = mfma16(cur.kA[0][ks], bV[ks], S0); S1 = mfma16(cur.kA[1][ks], bV[ks], S1); }
        *(LAS u32x2*)(SBuf + e_loc * 136 + 16 * dt0 + 4 * fq) = pack4(S0);
        *(LAS u32x2*)(SBuf + e_loc * 136 + 16 * (dt0 + 1) + 4 * fq) = pack4(S1);
        lds_barrier();
        cur = nxt;
    }
    if (DRY == 2) *(float*)((char*)p->out + 52428800 + (size_t)(blockIdx.x * NTHR + tid) * 4) = sink;
}

struct SsdOps { bf16x8 cB[4], bA[2], xB[4][2]; bf16x4 yp[2]; float elc, dec; };

template <int DRY>
__device__ __forceinline__ void ssd_scan(PP p, const int bh) {
    LAS char* lb = (LAS char*)dsm;
    asm volatile("" : "+v"(lb));
    LAS bf16_t* HT = (LAS bf16_t*)lb;
    const int tid = tid_opaque(), lane = tid & 63, wid = tid >> 6, fr = lane & 15, fq = lane >> 4;
    bf16_t* PROJ = (bf16_t*)(p->ws + OFF_PROJ);
    const float* SMALL = (const float*)(p->ws + OFF_SMALL);
    bf16_t* YPART = (bf16_t*)(p->ws + OFF_YPART);
    const int b = bh >> 4, hh = bh & 15, g = hh >> 3;
    const int i = wid & 3, ptb = 2 * (wid >> 2);
    for (int idx = tid; idx < 64 * 136 / 2; idx += NTHR) ((LAS unsigned*)HT)[idx] = 0u;
    f32x4 hs[4];
#pragma unroll
    for (int t = 0; t < 4; t++) hs[t] = (f32x4){0.f, 0.f, 0.f, 0.f};
    auto load = [&](int c, SsdOps& o) {
        const size_t row0 = (size_t)(b * 128 + c) * 64;
        const bf16_t* crow = PROJ + (row0 + 16 * i + fr) * LDP + XBC0 + 1280 + g * 128 + 8 * fq;
#pragma unroll
        for (int ks = 0; ks < 4; ks++) o.cB[ks] = *(const bf16x8*)(crow + 32 * ks);
        const int n = 16 * wid + fr;
        const bf16_t* brow_ = PROJ + (row0 + (n >> 1)) * LDP + XBC0 + 1024 + g * 128 + (n & 1) * 64 + 8 * fq;
#pragma unroll
        for (int ks = 0; ks < 2; ks++) o.bA[ks] = *(const bf16x8*)(brow_ + 32 * ks);
#pragma unroll
        for (int pt = 0; pt < 4; pt++) {
            const bf16_t* xrow = PROJ + (row0 + 16 * pt + fr) * LDP + XBC0 + hh * 64 + 8 * fq;
#pragma unroll
            for (int ks = 0; ks < 2; ks++) o.xB[pt][ks] = *(const bf16x8*)(xrow + 32 * ks);
        }
#pragma unroll
        for (int t = 0; t < 2; t++) o.yp[t] = *(const bf16x4*)(YPART + (row0 + 16 * i + fr) * 1024 + hh * 64 + 16 * (ptb + t) + 4 * fq);
        o.elc = SMALL[(row0 + 16 * i + fr) * 32 + hh];
        o.dec = SMALL[(row0 + 63) * 32 + hh];
    };
    float sink = 0.f;
    SsdOps cur, nxt;
    load(0, cur);
    nxt = cur;
    lds_barrier();
    for (int c = 0; c < 128; c++) {
        if (c + 1 < 128) load(c + 1, nxt);
        const LAS bf16_t* Hc = HT + (c & 1) * 8704;
        LAS bf16_t* Hn = HT + ((c & 1) ^ 1) * 8704;
        const size_t row0 = (size_t)(b * 128 + c) * 64;
#pragma unroll
        for (int t = 0; t < 2; t++) {
            const int pt = ptb + t;
            f32x4 a = {0.f, 0.f, 0.f, 0.f};
#pragma unroll
            for (int ks = 0; ks < 4; ks++) {
                const bf16x8 hf = *(const LAS bf16x8*)(Hc + (16 * pt + fr) * 136 + 32 * ks + 8 * fq);
                a = mfma16(hf, cur.cB[ks], a);
            }
            float yf[4];
            unpack4(cur.yp[t], yf);
            f32x4 y;
#pragma unroll
            for (int r = 0; r < 4; r++) y[r] = yf[r] + cur.elc * a[r];
            bf16_t* yd = YPART + (row0 + 16 * i + fr) * 1024 + hh * 64 + 16 * pt + 4 * fq;
            if (DRY) yd = (bf16_t*)((char*)p->out + 52428800 + (((size_t)((char*)yd - (char*)YPART)) & 0x7ffff8));
            if (DRY == 2) sink += y[0] + y[1] + y[2] + y[3]; else *(u32x2*)yd = pack4(y);
        }
#pragma unroll
        for (int pt = 0; pt < 4; pt++) {
            hs[pt] *= cur.dec;
#pragma unroll
            for (int ks = 0; ks < 2; ks++) hs[pt] = mfma16(cur.bA[ks], cur.xB[pt][ks], hs[pt]);
            *(LAS u32x2*)(Hn + (16 * pt + fr) * 136 + 16 * wid + 4 * fq) = pack4(hs[pt]);
        }
        lds_barrier();
        cur = nxt;
    }
    if (DRY == 2) *(float*)((char*)p->out + 52428800 + (size_t)(blockIdx.x * NTHR + tid) * 4) = sink;
}


constexpr int G2_SLOT0 = 13376, G2_SLOTB = 67072;
constexpr int G2_W = 0, G2_Q = 17408, G2_K = 34816, G2_A = 53248, G2_U = 62464;
struct GdnStage { u32x4 r[8]; float gl; };

template <int DRY, int MODE>
__device__ __forceinline__ void gdn_scan2(PP p, const int bh, const int es, const int c0) {
    LAS char* lb = (LAS char*)dsm;
    asm volatile("" : "+v"(lb));
    LAS bf16_t* SBuf = (LAS bf16_t*)lb;
    LAS bf16_t* VN = (LAS bf16_t*)(lb + 8704);
    LAS float* GL = (LAS float*)(lb + 13312);
    const int tid = tid_opaque(), lane = tid & 63, wid = __builtin_amdgcn_readfirstlane(tid >> 6), fr = lane & 15, fq = lane >> 4;
    bf16_t* PROJ = (bf16_t*)(p->ws + OFF_PROJ);
    const float* SMALL = (const float*)(p->ws + OFF_SMALL);
    const int b = bh >> 3, h = bh & 7;
    if (MODE == 1) {
        for (int idx = tid; idx < 32 * 136; idx += NTHR) { const int e_ = idx / 136, d_ = idx - e_ * 136; SBuf[idx] = (d_ == es * 32 + e_) ? (bf16_t)0x3F80 : (bf16_t)0; }
    } else {
        for (int idx = tid; idx < 32 * 136 / 2; idx += NTHR) ((LAS unsigned*)SBuf)[idx] = 0u;
    }
    const int lr = tid >> 4, c16 = tid & 15;
    const size_t rowb = (size_t)(b * 128) * 64;
    const char* gW = (const char*)PROJ + ((rowb + lr) * LDP + QKV0 + h * 128) * 2 + c16 * 16;
    const char* gU = (const char*)PROJ + ((rowb + es * 16 + (lr & 15)) * LDP + QKV0 + 2048 + h * 128) * 2 + c16 * 16;
    const char* gQ = (const char*)p->out + ((size_t)(b * 128 * 8 + h)) * 16384 + tid * 16;
    const char* gA = (const char*)p->out + OUT_ATTN_OFF + ((size_t)(b * 128 * 8 + h)) * 8192 + tid * 16;
    const float* gG = SMALL + (rowb + 63) * 32 + 16 + h;
    const unsigned dW = (unsigned)(lr * 136 + c16 * 8) * 2;
    const unsigned dK = (unsigned)((2 * lr + (c16 >> 3)) * 72 + (c16 & 7) * 8) * 2;
    const unsigned dA = (unsigned)((tid >> 3) * 72 + (tid & 7) * 8) * 2;
    const unsigned dU = (unsigned)((2 * (lr & 15) + (c16 >> 3)) * 72 + (c16 & 7) * 8) * 2;
    auto issue = [&](int c, GdnStage& st) {
        c = c > c0 + 63 ? c0 + 63 : c;
        if (DRY == 3) c = 0;
        const int cs = (DRY == 4) ? 0 : c, cq = (DRY == 5) ? 0 : c;
        const size_t co = (size_t)cs * 64 * LDP * 2;
#pragma unroll
        for (int j = 0; j < 2; j++) st.r[j] = *(const u32x4*)(gW + co + (size_t)j * 32 * LDP * 2);
#pragma unroll
        for (int j = 0; j < 2; j++) st.r[2 + j] = *(const u32x4*)(gW + 2048 + co + (size_t)j * 32 * LDP * 2);
#pragma unroll
        for (int j = 0; j < 2; j++) st.r[4 + j] = *(const u32x4*)(gQ + (size_t)cq * 8 * 16384 + j * 8192);
        st.r[6] = *(const u32x4*)(gA + (size_t)cq * 8 * 8192);
        if (wid < 4 && MODE == 0) st.r[7] = *(const u32x4*)(gU + co);
        st.gl = gG[(size_t)c * 64 * 32];
    };
    auto commit = [&](const GdnStage& st, int slot) {
        LAS char* sb = lb + G2_SLOT0 + slot * G2_SLOTB;
#pragma unroll
        for (int j = 0; j < 2; j++) *(LAS u32x4*)(sb + G2_W + dW + j * 32 * 272) = st.r[j];
#pragma unroll
        for (int j = 0; j < 2; j++) *(LAS u32x4*)(sb + G2_K + dK + j * 64 * 144) = st.r[2 + j];
#pragma unroll
        for (int j = 0; j < 2; j++) *(LAS u32x4*)(sb + G2_Q + dW + j * 32 * 272) = st.r[4 + j];
        *(LAS u32x4*)(sb + G2_A + dA) = st.r[6];
        if (wid < 4 && MODE == 0) *(LAS u32x4*)(sb + G2_U + dU) = st.r[7];
        if (tid == 0) GL[slot] = st.gl;
    };
    const int i = wid & 3, jc = wid >> 2;
    const int e_loc = 16 * jc + fr, e = es * 32 + e_loc;
    const int dt0 = 2 * i;
    f32x4 S0 = {0.f, 0.f, 0.f, 0.f}, S1 = {0.f, 0.f, 0.f, 0.f};
    if (MODE == 1) {
#pragma unroll
        for (int r = 0; r < 4; r++) {
            S0[r] = (16 * dt0 + 4 * fq + r == es * 32 + e_loc) ? 1.f : 0.f;
            S1[r] = (16 * (dt0 + 1) + 4 * fq + r == es * 32 + e_loc) ? 1.f : 0.f;
        }
    }
    float sink = 0.f;
    GdnStage R0, R1, R2, R3;
#pragma unroll
    for (int j = 0; j < 8; j++) { R0.r[j] = (u32x4){0u, 0u, 0u, 0u}; R1.r[j] = R0.r[j]; R2.r[j] = R0.r[j]; R3.r[j] = R0.r[j]; }
    issue(c0, R0);
    commit(R0, 0);
    issue(c0 + 1, R1); issue(c0 + 2, R2); issue(c0 + 3, R3);
    lds_barrier();
    auto step = [&](const int c, GdnStage& R, GdnStage& RI) {
        const int slot = c & 1;
        LAS char* sb = lb + G2_SLOT0 + slot * G2_SLOTB;
        commit(R, slot ^ 1);
        issue(c + 4, RI);
        f32x4 aP = {0.f, 0.f, 0.f, 0.f}, aO = {0.f, 0.f, 0.f, 0.f};
#pragma unroll
        for (int ks = 0; ks < 4; ks++) {
            const bf16x8 aw = *(const LAS bf16x8*)(sb + G2_W + ((16 * i + fr) * 136 + 32 * ks + 8 * fq) * 2);
            const bf16x8 aq = *(const LAS bf16x8*)(sb + G2_Q + ((16 * i + fr) * 136 + 32 * ks + 8 * fq) * 2);
            const bf16x8 bS = *(const LAS bf16x8*)(SBuf + e_loc * 136 + 32 * ks + 8 * fq);
            aP = mfma16(aw, bS, aP);
            aO = mfma16(aq, bS, aO);
        }
        {
            float uf[4] = {0.f, 0.f, 0.f, 0.f};
            if (MODE == 0) { const bf16x4 u = *(const LAS bf16x4*)(sb + G2_U + (e_loc * 72 + 16 * i + 4 * fq) * 2); unpack4(u, uf); }
            f32x4 vn;
#pragma unroll
            for (int r = 0; r < 4; r++) vn[r] = uf[r] - aP[r];
            *(LAS u32x2*)(VN + e_loc * 72 + 16 * i + 4 * fq) = pack4(vn);
        }
        lds_barrier();
        bf16x8 bV[2];
#pragma unroll
        for (int ks = 0; ks < 2; ks++) bV[ks] = *(const LAS bf16x8*)(VN + e_loc * 72 + 32 * ks + 8 * fq);
#pragma unroll
        for (int ks = 0; ks < 2; ks++) {
            const bf16x8 aa = *(const LAS bf16x8*)(sb + G2_A + ((16 * i + fr) * 72 + 32 * ks + 8 * fq) * 2);
            aO = mfma16(aa, bV[ks], aO);
        }
        {
            const size_t row0 = (size_t)(b * 128 + c) * 64;
            bf16_t* od = PROJ + (row0 + (e >> 1)) * LDP + QKV0 + 2048 + h * 128 + (e & 1) * 64 + 16 * i + 4 * fq;
            if (DRY) od = (bf16_t*)((char*)p->out + 52428800 + (((size_t)((char*)od - (char*)PROJ)) & 0x7ffff8));
            if (MODE == 1) {
                bf16_t* oi = (bf16_t*)((char*)p->out + OUT_OI_OFF) + ((size_t)((c - 64) * 16 + bh) * 64 + 16 * i + 4 * fq) * 128 + es * 32 + e_loc;
#pragma unroll
                for (int r = 0; r < 4; r++) oi[r * 128] = f2bf(aO[r]);
            } else if (DRY == 2) sink += aO[0] + aO[1] + aO[2] + aO[3]; else *(u32x2*)od = pack4(aO);
        }
        const float gl = GL[slot];
        S0 *= gl; S1 *= gl;
#pragma unroll
        for (int ks = 0; ks < 2; ks++) {
            const bf16x8 k0 = *(const LAS bf16x8*)(sb + G2_K + ((16 * dt0 + fr) * 72 + 32 * ks + 8 * fq) * 2);
            const bf16x8 k1 = *(const LAS bf16x8*)(sb + G2_K + ((16 * (dt0 + 1) + fr) * 72 + 32 * ks + 8 * fq) * 2);
            S0 = mfma16(k0, bV[ks], S0);
            S1 = mfma16(k1, bV[ks], S1);
        }
        *(LAS u32x2*)(SBuf + e_loc * 136 + 16 * dt0 + 4 * fq) = pack4(S0);
        *(LAS u32x2*)(SBuf + e_loc * 136 + 16 * (dt0 + 1) + 4 * fq) = pack4(S1);
        lds_barrier();
    };
    for (int c = c0; c < c0 + 64; c += 4) { step(c, R1, R0); step(c + 1, R2, R1); step(c + 2, R3, R2); step(c + 3, R0, R3); }
    if (MODE == 0 && c0 == 0) {
        bf16_t* sd = (bf16_t*)(p->ws + OFF_S64) + ((size_t)bh * 128 + e) * 128 + 4 * fq;
        *(u32x2*)(sd + 16 * dt0) = pack4(S0);
        *(u32x2*)(sd + 16 * (dt0 + 1)) = pack4(S1);
    }
    if (DRY == 2) *(float*)((char*)p->out + 52428800 + (size_t)(blockIdx.x * NTHR + tid) * 4) = sink;
}

constexpr int S2_SLOT0 = 34816, S2_SLOTB = 54784;
constexpr int S2_C = 0, S2_B = 17408, S2_X = 35840, S2_Y = 45056, S2_E = 54272;
struct SsdStage { u32x4 r[6]; float el; };

template <int DRY>
__device__ __forceinline__ void ssd_scan2(PP p, const int bh, const int c0) {
    LAS char* lb = (LAS char*)dsm;
    asm volatile("" : "+v"(lb));
    LAS bf16_t* HT = (LAS bf16_t*)lb;
    const int tid = tid_opaque(), lane = tid & 63, wid = __builtin_amdgcn_readfirstlane(tid >> 6), fr = lane & 15, fq = lane >> 4;
    bf16_t* PROJ = (bf16_t*)(p->ws + OFF_PROJ);
    const float* SMALL = (const float*)(p->ws + OFF_SMALL);
    bf16_t* YPART = (bf16_t*)(p->ws + OFF_YPART);
    const int b = bh >> 4, hh = bh & 15, g = hh >> 3;
    for (int idx = tid; idx < 64 * 136 / 2; idx += NTHR) ((LAS unsigned*)HT)[idx] = 0u;
    const int lr = tid >> 4, c16 = tid & 15, r8 = tid >> 3, c8 = tid & 7;
    const size_t rowb = (size_t)(b * 128) * 64;
    const char* gC = (const char*)PROJ + ((rowb + lr) * LDP + XBC0 + 1280 + g * 128) * 2 + c16 * 16;
    const char* gB = (const char*)PROJ + ((rowb + lr) * LDP + XBC0 + 1024 + g * 128) * 2 + c16 * 16;
    const char* gX = (const char*)PROJ + ((rowb + r8) * LDP + XBC0 + hh * 64) * 2 + c8 * 16;
    const char* gY = (const char*)YPART + ((rowb + r8) * 1024 + hh * 64) * 2 + c8 * 16;
    const float* gE = SMALL + (rowb + (tid & 63)) * 32 + hh;
    const unsigned dC = (unsigned)(lr * 136 + c16 * 8) * 2;
    const unsigned dB = (unsigned)((2 * lr + (c16 >> 3)) * 72 + (c16 & 7) * 8) * 2;
    const unsigned dX = (unsigned)(r8 * 72 + c8 * 8) * 2;
    auto issue = [&](int c, SsdStage& st) {
        c = c > c0 + 63 ? c0 + 63 : c;
        if (DRY == 3) c = 0;
        const size_t co = (size_t)((DRY == 4) ? 0 : c) * 64 * LDP * 2;
#pragma unroll
        for (int j = 0; j < 2; j++) st.r[j] = *(const u32x4*)(gC + co + (size_t)j * 32 * LDP * 2);
#pragma unroll
        for (int j = 0; j < 2; j++) st.r[2 + j] = *(const u32x4*)(gB + co + (size_t)j * 32 * LDP * 2);
        st.r[4] = *(const u32x4*)(gX + co);
        st.r[5] = *(const u32x4*)(gY + (size_t)c * 64 * 2048);
        st.el = gE[(size_t)c * 64 * 32];
    };
    auto commit = [&](const SsdStage& st, int slot) {
        LAS char* sb = lb + S2_SLOT0 + slot * S2_SLOTB;
#pragma unroll
        for (int j = 0; j < 2; j++) *(LAS u32x4*)(sb + S2_C + dC + j * 32 * 272) = st.r[j];
#pragma unroll
        for (int j = 0; j < 2; j++) *(LAS u32x4*)(sb + S2_B + dB + j * 64 * 144) = st.r[2 + j];
        *(LAS u32x4*)(sb + S2_X + dX) = st.r[4];
        *(LAS u32x4*)(sb + S2_Y + dX) = st.r[5];
        if (tid < 64) *(LAS float*)(sb + S2_E + tid * 4) = st.el;
    };
    const int i = wid & 3, ptb = 2 * (wid >> 2);
    f32x4 hs[4];
#pragma unroll
    for (int c = 0; c < 4; c++) hs[c] = (f32x4){0.f, 0.f, 0.f, 0.f};
    float sink = 0.f;
    SsdStage R0, R1, R2, R3;
    issue(c0, R0);
    commit(R0, 0);
    issue(c0 + 1, R1); issue(c0 + 2, R2); issue(c0 + 3, R3);
    float cum = 1.f;
    lds_barrier();
    auto step = [&](const int c, SsdStage& R, SsdStage& RI) {
        const int slot = c & 1;
        LAS char* sb = lb + S2_SLOT0 + slot * S2_SLOTB;
        commit(R, slot ^ 1);
        issue(c + 4, RI);
        const LAS bf16_t* Hc = HT + slot * 8704;
        LAS bf16_t* Hn = HT + (slot ^ 1) * 8704;
        const size_t row0 = (size_t)(b * 128 + c) * 64;
        const float elc = *(const LAS float*)(sb + S2_E + (16 * i + fr) * 4);
        const float dec = *(const LAS float*)(sb + S2_E + 63 * 4);
        if (c0 == 64) { if (tid == 0) ((float*)(p->ws + OFF_CUM))[bh * 64 + (c - 64)] = cum; cum *= dec; }
#pragma unroll
        for (int tt = 0; tt < 2; tt++) {
            const int pt = ptb + tt;
            f32x4 a = {0.f, 0.f, 0.f, 0.f};
#pragma unroll
            for (int ks = 0; ks < 4; ks++) {
                const bf16x8 cB = *(const LAS bf16x8*)(sb + S2_C + ((16 * i + fr) * 136 + 32 * ks + 8 * fq) * 2);
                const bf16x8 hf = *(const LAS bf16x8*)(Hc + (16 * pt + fr) * 136 + 32 * ks + 8 * fq);
                a = mfma16(hf, cB, a);
            }
            const bf16x4 yp = *(const LAS bf16x4*)(sb + S2_Y + ((16 * i + fr) * 72 + 16 * pt + 4 * fq) * 2);
            float yf[4];
            unpack4(yp, yf);
            f32x4 y;
#pragma unroll
            for (int r = 0; r < 4; r++) y[r] = yf[r] + elc * a[r];
            bf16_t* yd = YPART + (row0 + 16 * i + fr) * 1024 + hh * 64 + 16 * pt + 4 * fq;
            if (DRY) yd = (bf16_t*)((char*)p->out + 52428800 + (((size_t)((char*)yd - (char*)YPART)) & 0x7ffff8));
            if (DRY == 2) sink += y[0] + y[1] + y[2] + y[3]; else *(u32x2*)yd = pack4(y);
        }
#pragma unroll
        for (int pt = 0; pt < 4; pt++) {
            hs[pt] *= dec;
#pragma unroll
            for (int ks = 0; ks < 2; ks++) {
                const bf16x8 bA = *(const LAS bf16x8*)(sb + S2_B + ((16 * wid + fr) * 72 + 32 * ks + 8 * fq) * 2);
                const bf16x8 xB = *(const LAS bf16x8*)(sb + S2_X + ((16 * pt + fr) * 72 + 32 * ks + 8 * fq) * 2);
                hs[pt] = mfma16(bA, xB, hs[pt]);
            }
            *(LAS u32x2*)(Hn + (16 * pt + fr) * 136 + 16 * wid + 4 * fq) = pack4(hs[pt]);
        }
        lds_barrier();
    };
    for (int c = c0; c < c0 + 64; c += 4) { step(c, R1, R0); step(c + 1, R2, R1); step(c + 2, R3, R2); step(c + 3, R0, R3); }
    if (c0 == 0) {
        bf16_t* hd = (bf16_t*)(p->ws + OFF_H64) + (size_t)bh * 64 * 128 + 16 * wid + 4 * fq;
#pragma unroll
        for (int pt = 0; pt < 4; pt++) *(u32x2*)(hd + (16 * pt + fr) * 128) = pack4(hs[pt]);
    }
    if (DRY == 2) *(float*)((char*)p->out + 52428800 + (size_t)(blockIdx.x * NTHR + tid) * 4) = sink;
}

template <int DRY>
__device__ __forceinline__ void phase_c(PP p) {
    for (int it = blockIdx.x; it < 256; it += gridDim.x) {
        if (it < 192) {
            const int r = it & 63, role = it >> 6;
            const int bh = (r & 7) + 8 * ((r >> 3) >> 2), es = (r >> 3) & 3;
            if (role == 0) gdn_scan2<DRY, 0>(p, bh, es, 0);
            else if (role == 1) gdn_scan2<DRY, 0>(p, bh, es, 64);
            else gdn_scan2<DRY, 1>(p, bh, es, 64);
        } else {
            const int r = it - 192, combo = r & 7, hl = r >> 3;
            ssd_scan2<DRY>(p, (combo >> 2) * 16 + ((combo >> 1) & 1) * 8 + hl, (combo & 1) * 64);
        }
        __syncthreads();
    }
}

template <int DRY>
__device__ __forceinline__ void phase_fix(PP p) {
    const int tid = tid_opaque(), lane = tid & 63, wid = tid >> 6, fr = lane & 15, fq = lane >> 4;
    bf16_t* PROJ = (bf16_t*)(p->ws + OFF_PROJ);
    const float* SMALL = (const float*)(p->ws + OFF_SMALL);
    bf16_t* YPART = (bf16_t*)(p->ws + OFF_YPART);
    struct SF { bf16x8 hA[2][4]; bf16x4 y4[2]; float sc; };
    const int i = wid & 3, ptb = 2 * (wid >> 2);
    for (int gi = blockIdx.x; gi < 256; gi += gridDim.x) {
        const int b = gi >> 7, g = (gi >> 6) & 1, cc = gi & 63;
        const size_t row0 = (size_t)(b * 128 + 64 + cc) * 64;
        const bf16_t* crow = PROJ + (row0 + 16 * i + fr) * LDP + XBC0 + 1280 + g * 128 + 8 * fq;
        bf16x8 cB[4];
#pragma unroll
        for (int ks = 0; ks < 4; ks++) cB[ks] = *(const bf16x8*)(crow + 32 * ks);
        auto sload = [&](int hl, SF& f) {
            const int hh = 8 * g + hl, bh = b * 16 + hh;
            f.sc = SMALL[(row0 + 16 * i + fr) * 32 + hh] * ((const float*)(p->ws + OFF_CUM))[bh * 64 + cc];
#pragma unroll
            for (int tt = 0; tt < 2; tt++) {
                const bf16_t* hp = (const bf16_t*)(p->ws + OFF_H64) + ((size_t)bh * 64 + 16 * (ptb + tt) + fr) * 128 + 8 * fq;
#pragma unroll
                for (int ks = 0; ks < 4; ks++) f.hA[tt][ks] = *(const bf16x8*)(hp + 32 * ks);
                f.y4[tt] = *(const bf16x4*)(YPART + (row0 + 16 * i + fr) * 1024 + hh * 64 + 16 * (ptb + tt) + 4 * fq);
            }
        };
        auto sfinish = [&](int hl, const SF& f) {
            const int hh = 8 * g + hl;
#pragma unroll
            for (int tt = 0; tt < 2; tt++) {
                f32x4 acc = {0.f, 0.f, 0.f, 0.f};
#pragma unroll
                for (int ks = 0; ks < 4; ks++) acc = mfma16(f.hA[tt][ks], cB[ks], acc);
                float yf[4];
                unpack4(f.y4[tt], yf);
                f32x4 y;
#pragma unroll
                for (int r = 0; r < 4; r++) y[r] = yf[r] + f.sc * acc[r];
                *(u32x2*)(YPART + (row0 + 16 * i + fr) * 1024 + hh * 64 + 16 * (ptb + tt) + 4 * fq) = pack4(y);
            }
        };
        SF fa, fb;
        sload(0, fa);
#pragma unroll
        for (int hl = 0; hl < 8; hl += 2) {
            sload(hl + 1, fb);
            sfinish(hl, fa);
            if (hl + 2 < 8) sload(hl + 2, fa);
            sfinish(hl + 1, fb);
        }
    }
}

template <int DRY>
__device__ __forceinline__ void phase_d1(PP p) {
    const int tid = tid_opaque(), lane = tid & 63, wid = tid >> 6;
    bf16_t* PROJ = (bf16_t*)(p->ws + OFF_PROJ);
    const bf16_t* YPART = (const bf16_t*)(p->ws + OFF_YPART);
    {
        LAS bf16_t* YL = (LAS bf16_t*)dsm;
        const float* SMALL = (const float*)(p->ws + OFF_SMALL);
        const int fr = lane & 15, fq = lane >> 4, i4 = wid & 3, ptb = 2 * (wid >> 2);
        struct SF { bf16x8 hA[2][4]; bf16x4 y4[2]; float sc; };
        for (int gi = blockIdx.x; gi < 512; gi += gridDim.x) {
            const int k = gi >> 8, j = gi & 255, b = k, g = j >> 7, c = (j & 127) ^ (k << 6);
            const size_t row0 = (size_t)(b * 128 + c) * 64;
            const bool fix = c >= 64;
            bf16x8 yv[8], zv[8];
#pragma unroll
            for (int t8 = 0; t8 < 8; t8++) {
                const size_t tok = row0 + wid * 8 + t8;
                zv[t8] = *(const bf16x8*)(PROJ + tok * LDP + g * 512 + lane * 8);
                if (!fix) yv[t8] = *(const bf16x8*)(YPART + tok * 1024 + g * 512 + lane * 8);
            }
            if (fix) {
                const int cc = c - 64;
                const bf16_t* crow = PROJ + (row0 + 16 * i4 + fr) * LDP + XBC0 + 1280 + g * 128 + 8 * fq;
                bf16x8 cB[4];
#pragma unroll
                for (int ks = 0; ks < 4; ks++) cB[ks] = *(const bf16x8*)(crow + 32 * ks);
                auto sload = [&](int hl, SF& f) {
                    const int hh = 8 * g + hl, bh = b * 16 + hh;
                    f.sc = SMALL[(row0 + 16 * i4 + fr) * 32 + hh] * ((const float*)(p->ws + OFF_CUM))[bh * 64 + cc];
#pragma unroll
                    for (int tt = 0; tt < 2; tt++) {
                        const bf16_t* hp = (const bf16_t*)(p->ws + OFF_H64) + ((size_t)bh * 64 + 16 * (ptb + tt) + fr) * 128 + 8 * fq;
#pragma unroll
                        for (int ks = 0; ks < 4; ks++) f.hA[tt][ks] = *(const bf16x8*)(hp + 32 * ks);
                        f.y4[tt] = *(const bf16x4*)(YPART + (row0 + 16 * i4 + fr) * 1024 + hh * 64 + 16 * (ptb + tt) + 4 * fq);
                    }
                };
                auto sfinish = [&](int hl, const SF& f) {
#pragma unroll
                    for (int tt = 0; tt < 2; tt++) {
                        f32x4 acc = {0.f, 0.f, 0.f, 0.f};
#pragma unroll
                        for (int ks = 0; ks < 4; ks++) acc = mfma16(f.hA[tt][ks], cB[ks], acc);
                        float yf[4];
                        unpack4(f.y4[tt], yf);
                        f32x4 y;
#pragma unroll
                        for (int r = 0; r < 4; r++) y[r] = yf[r] + f.sc * acc[r];
                        *(LAS u32x2*)(YL + (16 * i4 + fr) * 520 + hl * 64 + 16 * (ptb + tt) + 4 * fq) = pack4(y);
                    }
                };
                SF fa, fb;
                sload(0, fa);
#pragma unroll
                for (int hl = 0; hl < 8; hl += 2) {
                    sload(hl + 1, fb);
                    sfinish(hl, fa);
                    if (hl + 2 < 8) sload(hl + 2, fa);
                    sfinish(hl + 1, fb);
                }
                __syncthreads();
#pragma unroll
                for (int t8 = 0; t8 < 8; t8++) yv[t8] = *(const LAS bf16x8*)(YL + (wid * 8 + t8) * 520 + lane * 8);
            }
            const float4 w0 = *(const float4*)(p->ssd_norm_w + g * 512 + lane * 8), w1 = *(const float4*)(p->ssd_norm_w + g * 512 + lane * 8 + 4);
#pragma unroll
            for (int t8 = 0; t8 < 8; t8++) {
                const size_t tok = row0 + wid * 8 + t8;
                float y[8], z[8], v[8];
                unpack8(yv[t8], y); unpack8(zv[t8], z);
                float ss = 0.f;
#pragma unroll
                for (int i = 0; i < 8; i++) { v[i] = y[i] * silu_f(z[i]); ss += v[i] * v[i]; }
                ss = wave_sum(ss);
                const float rs = rsqrtf(ss * (1.f / 512.f) + 1e-6f);
                v[0] *= rs * w0.x; v[1] *= rs * w0.y; v[2] *= rs * w0.z; v[3] *= rs * w0.w;
                v[4] *= rs * w1.x; v[5] *= rs * w1.y; v[6] *= rs * w1.z; v[7] *= rs * w1.w;
                if (DRY) *(u32x4*)((char*)p->out + (((tok * LDP + XBC0 + g * 512 + lane * 8) * 2) & 0x3fffff0)) = pack8(v);
                else *(u32x4*)(PROJ + tok * LDP + XBC0 + g * 512 + lane * 8) = pack8(v);
            }
            if (fix) __syncthreads();
        }
    }
    LAS float* OT = (LAS float*)dsm;
    struct D1In { bf16x8 a, b; unsigned gg[8]; };
    auto d1load = [&](int it, D1In& in) {
        const int ch = it >> 3, h = it & 7;
        const size_t row0 = (size_t)ch * 64;
        const int e = tid >> 2, lq = tid & 3;
        const bf16_t* src = PROJ + (row0 + (e >> 1)) * LDP + QKV0 + 2048 + h * 128 + (e & 1) * 64 + lq * 16;
        in.a = *(const bf16x8*)src; in.b = *(const bf16x8*)(src + 8);
#pragma unroll
        for (int tk = 0; tk < 8; tk++) in.gg[tk] = *(const unsigned*)(PROJ + (row0 + wid * 8 + tk) * LDP + GATE0 + h * 128 + 2 * lane);
    };
    D1In cur, nxt;
    if ((int)blockIdx.x < 2048) d1load(blockIdx.x, cur);
    nxt = cur;
    const float w0 = p->gdn_norm_w[2 * lane], w1 = p->gdn_norm_w[2 * lane + 1];
    for (int it = blockIdx.x; it < 2048; it += gridDim.x) {
        const int ch = it >> 3, h = it & 7;
        const size_t row0 = (size_t)ch * 64;
        {
            const int e = tid >> 2, lq = tid & 3;
            float fa[8], fb[8];
            unpack8(cur.a, fa); unpack8(cur.b, fb);
#pragma unroll
            for (int t = 0; t < 8; t++) { OT[(lq * 16 + t) * 129 + e] = fa[t]; OT[(lq * 16 + 8 + t) * 129 + e] = fb[t]; }
        }
        const bool fix = (ch & 127) >= 64;
        bf16x8 fS[4], fI[4][4];
        if (fix) {
            const int fr = lane & 15, fq = lane >> 4, bh = (ch >> 7) * 8 + h, cc = (ch & 127) - 64;
            const bf16_t* sp = (const bf16_t*)(p->ws + OFF_S64) + ((size_t)bh * 128 + 16 * wid + fr) * 128 + 8 * fq;
            const bf16_t* oi = (const bf16_t*)((const char*)p->out + OUT_OI_OFF) + ((size_t)(cc * 16 + bh) * 64 + fr) * 128 + 8 * fq;
#pragma unroll
            for (int ks = 0; ks < 4; ks++) fS[ks] = *(const bf16x8*)(sp + 32 * ks);
#pragma unroll
            for (int lt = 0; lt < 4; lt++)
#pragma unroll
                for (int ks = 0; ks < 4; ks++) fI[lt][ks] = *(const bf16x8*)(oi + (size_t)(16 * lt) * 128 + 32 * ks);
        }
        if (it + (int)gridDim.x < 2048) d1load(it + gridDim.x, nxt);
        __syncthreads();
        if (fix) {
            const int fr = lane & 15, fq = lane >> 4;
#pragma unroll
            for (int lt = 0; lt < 4; lt++) {
                f32x4 acc = {0.f, 0.f, 0.f, 0.f};
#pragma unroll
                for (int ks = 0; ks < 4; ks++) acc = mfma16(fI[lt][ks], fS[ks], acc);
#pragma unroll
                for (int r = 0; r < 4; r++) OT[(16 * lt + 4 * fq + r) * 129 + 16 * wid + fr] += acc[r];
            }
            __syncthreads();
        }
#pragma unroll
        for (int tk = 0; tk < 8; tk++) {
            const int l = wid * 8 + tk;
            const float o0 = OT[l * 129 + 2 * lane], o1 = OT[l * 129 + 2 * lane + 1];
            const float ss = wave_sum(o0 * o0 + o1 * o1);
            const float rs = rsqrtf(ss * (1.f / 128.f) + 1e-6f);
            const unsigned gg = cur.gg[tk];
            const float r0 = o0 * rs * w0 * silu_f(bflo(gg)), r1 = o1 * rs * w1 * silu_f(bfhi(gg));
            if (DRY) *(unsigned*)((char*)p->out + ((((row0 + l) * LDP + QKV0 + 2048 + h * 128 + 2 * lane) * 2) & 0x3fffffc)) = pk2(r0, r1);
            else *(unsigned*)(PROJ + (row0 + l) * LDP + QKV0 + 2048 + h * 128 + 2 * lane) = pk2(r0, r1);
        }
        __syncthreads();
        cur = nxt;
    }
}

__device__ __forceinline__ void phase_final(PP p) {
    const int tid = tid_opaque(), lane = tid & 63, wid = tid >> 6;
    for (int r0 = (blockIdx.x * 8 + wid) * 4; r0 < MTOK; r0 += gridDim.x * 32) {
        float4 v[4][4];
#pragma unroll
        for (int rr = 0; rr < 4; rr++) {
            const float4* xr = (const float4*)(p->out + (size_t)(r0 + rr) * DM);
#pragma unroll
            for (int i = 0; i < 4; i++) v[rr][i] = xr[lane + 64 * i];
        }
#pragma unroll
        for (int rr = 0; rr < 4; rr++) {
            float4* xr = (float4*)(p->out + (size_t)(r0 + rr) * DM);
            float ss = 0.f;
#pragma unroll
            for (int i = 0; i < 4; i++) ss += v[rr][i].x * v[rr][i].x + v[rr][i].y * v[rr][i].y + v[rr][i].z * v[rr][i].z + v[rr][i].w * v[rr][i].w;
            ss = wave_sum(ss);
            const float rs = rsqrtf(ss * (1.f / DM) + 1e-6f);
#pragma unroll
            for (int i = 0; i < 4; i++) {
                const float4 w = ((const float4*)p->final_norm_w)[lane + 64 * i];
                xr[lane + 64 * i] = make_float4(v[rr][i].x * rs * w.x, v[rr][i].y * rs * w.y, v[rr][i].z * rs * w.z, v[rr][i].w * rs * w.w);
            }
        }
    }
}

#define LAUNDER asm volatile("" : "+s"(p))
#ifndef PROG
#define PROG {0, 1, 2, 3, 4, 5}
#endif
constexpr int kProg[] = PROG;
constexpr int kProgLen = sizeof(kProg) / sizeof(int);

template <int PH>
__device__ __forceinline__ void run_phase(PP p, unsigned& bk) {
    if constexpr (PH == 0) phase_prep(p, true);
    else if constexpr (PH == 20) phase_prep(p, false);
    else if constexpr (PH == 1) phase_gemm<1>(p, bk);
    else if constexpr (PH == 2) phase_b<0>(p);
    else if constexpr (PH == 15) { }
    else if constexpr (PH == 12) phase_b<12>(p);
    else if constexpr (PH == 13) phase_b<13>(p);
    else if constexpr (PH == 14) phase_b<14>(p);
    else if constexpr (PH == 17) phase_b<17>(p);
    else if constexpr (PH == 18) phase_b<18>(p);
    else if constexpr (PH == 3) phase_c<0>(p);
    else if constexpr (PH == 7) phase_c<1>(p);
    else if constexpr (PH == 8) phase_c<2>(p);
    else if constexpr (PH == 9) phase_c<3>(p);
    else if constexpr (PH == 10) phase_c<4>(p);
    else if constexpr (PH == 11) phase_c<5>(p);
    else if constexpr (PH == 24) phase_fix<0>(p);
    else if constexpr (PH == 4) phase_d1<0>(p);
    else if constexpr (PH == 16) phase_d1<1>(p);
    else if constexpr (PH == 5) phase_gemm<2>(p, bk);
    else phase_final(p);
}
template <int I>
__device__ __forceinline__ void run_prog(PP p, cg::grid_group& grid, unsigned& bk) {
    if constexpr (I < kProgLen) {
        if (I > 0) {
            if ((gridDim.x & 7u) == 0u) fast_grid_barrier((unsigned*)(p->ws + OFF_BAR), bk);
            else grid.sync();
        }
        LAUNDER;
        run_phase<kProg[I]>(p, bk);
        run_prog<I + 1>(p, grid, bk);
    }
}

template <int LO, int HI>
__global__ void __launch_bounds__(512) hybrid_mega(Params p_arg) {
    cg::grid_group grid = cg::this_grid();
    PP p = (PP)__builtin_amdgcn_kernarg_segment_ptr();
    unsigned bk = 0u;
    if constexpr (LO == 0 && HI == 6) run_prog<0>(p, grid, bk);
    else { LAUNDER; run_phase<LO>(p, bk); }
}

template <int PH>
static void launch_one(const Params& p, int grid_blocks, hipStream_t stream) {
    hipFuncSetAttribute((const void*)hybrid_mega<PH, PH>, hipFuncAttributeMaxDynamicSharedMemorySize, LDS_BYTES);
    hipLaunchKernelGGL((hybrid_mega<PH, PH>), dim3(grid_blocks), dim3(NTHR), LDS_BYTES, stream, p);
}

extern "C" void kernel_launch(void* const* d_in, const int* in_sizes, int n_in, void* d_out, int out_size, void* d_ws, size_t ws_size,
                              hipStream_t stream) {
    static int grid_blocks = 0;
    if (grid_blocks == 0) {
        int dev = 0, cus = 0, per_cu = 0;
        (void)hipGetDevice(&dev);
        (void)hipDeviceGetAttribute(&cus, hipDeviceAttributeMultiprocessorCount, dev);
#if N_LAUNCH_MODE == 1
        (void)hipFuncSetAttribute((const void*)hybrid_mega<0, 6>, hipFuncAttributeMaxDynamicSharedMemorySize, LDS_BYTES);
        (void)hipOccupancyMaxActiveBlocksPerMultiprocessor(&per_cu, (const void*)hybrid_mega<0, 6>, NTHR, LDS_BYTES);
#else
        per_cu = 1;
#endif
        if (per_cu < 1) { fprintf(stderr, "occupancy query returned %d\n", per_cu); per_cu = 1; }
        if (per_cu > 1) per_cu = 1;
        grid_blocks = cus * per_cu;
        if (ws_size < WS_NEED) fprintf(stderr, "workspace too small: %zu < %zu\n", ws_size, (size_t)WS_NEED);
    }
    Params p{};
    p.x = (const float*)d_in[0]; p.norm_w = (const float*)d_in[1]; p.w_in = (const float*)d_in[2];
    p.ssd_conv_w = (const float*)d_in[3]; p.ssd_conv_b = (const float*)d_in[4]; p.ssd_dt_bias = (const float*)d_in[5];
    p.ssd_a_log = (const float*)d_in[6]; p.ssd_d = (const float*)d_in[7]; p.ssd_norm_w = (const float*)d_in[8];
    p.gdn_conv_w = (const float*)d_in[9]; p.gdn_dt_bias = (const float*)d_in[10]; p.gdn_a_log = (const float*)d_in[11];
    p.gdn_norm_w = (const float*)d_in[12]; p.w_out = (const float*)d_in[13]; p.final_norm_w = (const float*)d_in[14];
    p.out = (float*)d_out; p.ws = (char*)d_ws;
#if N_LAUNCH_MODE == 1
    (void)hipMemsetAsync((char*)d_ws + OFF_BAR, 0, BAR_BYTES, stream);
    void* args[] = {&p};
    hipError_t e = hipLaunchCooperativeKernel((const void*)hybrid_mega<0, 6>, dim3(grid_blocks), dim3(NTHR), args, LDS_BYTES, stream);
    if (e != hipSuccess) fprintf(stderr, "cooperative launch failed: %s (grid %d)\n", hipGetErrorString(e), grid_blocks);
#else
    launch_one<0>(p, grid_blocks, stream); launch_one<1>(p, grid_blocks, stream);
    launch_one<2>(p, grid_blocks, stream);
#ifndef SKIP_MID
    launch_one<3>(p, grid_blocks, stream);
#endif
    launch_one<4>(p, grid_blocks, stream);
    launch_one<5>(p, grid_blocks, stream);
    launch_one<6>(p, grid_blocks, stream);
#endif
}
```
